# Optimizing an MI355X kernel written in HIP

```python
import math
import jax, jax.numpy as jnp
from jax import lax
import numpy as np

D_MODEL = 1024
BATCH = 16
SEQ = 2048
DEPTH = 2

D_MIX = D_MODEL
D_ATTN = D_MIX // 2
D_CONV = D_MIX - D_ATTN
HEAD_DIM = 64
N_HEADS = D_ATTN // HEAD_DIM
CONV_GROUP = 64
N_CONV_GROUPS = D_CONV // CONV_GROUP
DILATED_CONFIGS = ((128, 1), (512, 4), (2048, 16))
BAND_BLOCK = 128
CONV_WIDTH = 3
FFN_CONV_WIDTH = 3
D_FF = 2816
EPS = 1e-6

kernel_name = "hybrid_dilated_attn_shortconv_convffn"


def rmsnorm(x, g):
    xf = x.astype(jnp.float32)
    y = xf * lax.rsqrt(jnp.mean(xf * xf, axis=-1, keepdims=True) + EPS)
    return (y * g.astype(jnp.float32)).astype(x.dtype)


def group_rmsnorm(x, g, n_groups):
    shp = x.shape
    xg = x.reshape(*shp[:-1], n_groups, shp[-1] // n_groups)
    return rmsnorm(xg, g.reshape(n_groups, -1)).reshape(shp)


def causal_dwconv(u, w):
    K = w.shape[0]
    S = u.shape[1]
    up = jnp.pad(u, ((0, 0), (K - 1, 0), (0, 0)))
    return sum(up[:, k:k + S] * w[k].astype(u.dtype) for k in range(K))


def alibi_slopes(n):
    return 2.0 ** (-8.0 * jnp.arange(1, n + 1, dtype=jnp.float32) / n)


def dilated_branch(q, k, v, slopes, window, dilation):
    B, H, S, hd = q.shape
    span = window // dilation
    L = S // dilation
    nb = -(-L // BAND_BLOCK)
    Lp = nb * BAND_BLOCK

    def to_blocks(t):
        t = t.reshape(B, H, L, dilation, hd).transpose(0, 1, 3, 2, 4)
        t = jnp.pad(t, ((0, 0), (0, 0), (0, 0), (0, Lp - L), (0, 0)))
        return t.reshape(B, H, dilation, nb, BAND_BLOCK, hd)

    def with_prev(t):
        prev = jnp.pad(t, ((0, 0), (0, 0), (0, 0), (1, 0), (0, 0), (0, 0)))[:, :, :, :-1]
        return jnp.concatenate([prev, t], axis=-2)

    qb, kb, vb = to_blocks(q), to_blocks(k), to_blocks(v)
    kk, vv = with_prev(kb), with_prev(vb)
    s = jnp.einsum('bhrnqd,bhrnkd->bhrnqk', qb, kk)
    i = jnp.arange(BAND_BLOCK)[:, None]
    j = jnp.arange(2 * BAND_BLOCK)[None, :]
    dist = BAND_BLOCK + i - j
    blk = jnp.arange(nb)[:, None, None]
    valid = (dist >= 0) & (dist <= span) & ((blk > 0) | (j >= BAND_BLOCK))
    bias = -(slopes * dilation).reshape(1, H, 1, 1, 1, 1) * dist.astype(jnp.float32)
    s = jnp.where(valid, s + bias, -jnp.inf)
    m = jnp.max(s, axis=-1)
    p = jnp.exp(s - m[..., None])
    l = jnp.sum(p, axis=-1)
    o = jnp.einsum('bhrnqk,bhrnkd->bhrnqd', p, vv)

    def from_blocks(t):
        rest = t.shape[5:]
        t = t.reshape(B, H, dilation, Lp, *rest)[:, :, :, :L]
        t = jnp.moveaxis(t, 2, 3)
        return t.reshape(B, H, S, *rest)

    return from_blocks(o), from_blocks(m), from_blocks(l)


def dilated_attention(q, k, v):
    slopes = alibi_slopes(q.shape[1])
    outs = [dilated_branch(q, k, v, slopes, w, d) for (w, d) in DILATED_CONFIGS]
    m_max = jnp.max(jnp.stack([m for (_, m, _) in outs]), axis=0)
    num = sum(o * jnp.exp(m - m_max)[..., None] for (o, m, _) in outs)
    den = sum(l * jnp.exp(m - m_max) for (_, m, l) in outs)
    return num / den[..., None]


def hybrid_mixer(h, w_in, mix_conv_w, attn_out_g, conv_out_g, w_out):
    B, S, _ = h.shape
    proj = h @ w_in
    q, k, v, gate_b, gate_c, u = jnp.split(
        proj, [D_ATTN, 2 * D_ATTN, 3 * D_ATTN, 3 * D_ATTN + D_CONV, 3 * D_ATTN + 2 * D_CONV], axis=-1)

    def heads(t):
        return t.reshape(B, S, N_HEADS, HEAD_DIM).transpose(0, 2, 1, 3).astype(jnp.float32)

    attn = dilated_attention(heads(q) * (HEAD_DIM ** -0.5), heads(k), heads(v))
    attn = attn.transpose(0, 2, 1, 3).reshape(B, S, D_ATTN).astype(h.dtype)
    attn = group_rmsnorm(attn, attn_out_g, N_HEADS)

    y = gate_b * causal_dwconv(gate_c * u, mix_conv_w)
    y = group_rmsnorm(y, conv_out_g, N_CONV_GROUPS)

    return jnp.concatenate([attn, y], axis=-1) @ w_out


def conv_glu_ffn(h, ffn_up, ffn_conv_w, ffn_down):
    up = causal_dwconv(h @ ffn_up, ffn_conv_w)
    gate, val = jnp.split(up, 2, axis=-1)
    return (jax.nn.silu(gate) * val) @ ffn_down


def setup_inputs(seed: int = 0) -> dict:
    key = jax.random.key(seed)
    ks = jax.random.split(key, 12)
    f32 = jnp.float32
    n = jax.random.normal
    d_in = 3 * D_ATTN + 3 * D_CONV
    return {
        "x": n(ks[0], (BATCH, SEQ, D_MODEL), f32),
        "norm1_g": 1.0 + 0.02 * n(ks[1], (DEPTH, D_MODEL), f32),
        "w_in": n(ks[2], (DEPTH, D_MODEL, d_in), f32) * D_MODEL ** -0.5,
        "mix_conv_w": n(ks[3], (DEPTH, CONV_WIDTH, D_CONV), f32) * CONV_WIDTH ** -0.5,
        "attn_out_g": 1.0 + 0.02 * n(ks[4], (DEPTH, D_ATTN), f32),
        "conv_out_g": 1.0 + 0.02 * n(ks[5], (DEPTH, D_CONV), f32),
        "w_out": n(ks[6], (DEPTH, D_MIX, D_MODEL), f32) * D_MIX ** -0.5,
        "norm2_g": 1.0 + 0.02 * n(ks[7], (DEPTH, D_MODEL), f32),
        "ffn_up": n(ks[8], (DEPTH, D_MODEL, 2 * D_FF), f32) * D_MODEL ** -0.5,
        "ffn_conv_w": n(ks[9], (DEPTH, FFN_CONV_WIDTH, 2 * D_FF), f32) * FFN_CONV_WIDTH ** -0.5,
        "ffn_down": n(ks[10], (DEPTH, D_FF, D_MODEL), f32) * D_FF ** -0.5,
        "final_norm_g": 1.0 + 0.02 * n(ks[11], (D_MODEL,), f32),
    }


def reference(x, norm1_g, w_in, mix_conv_w, attn_out_g, conv_out_g, w_out,
              norm2_g, ffn_up, ffn_conv_w, ffn_down, final_norm_g):
    for layer in range(DEPTH):
        h = rmsnorm(x, norm1_g[layer])
        x = x + hybrid_mixer(h, w_in[layer], mix_conv_w[layer], attn_out_g[layer],
                             conv_out_g[layer], w_out[layer])
        h = rmsnorm(x, norm2_g[layer])
        x = x + conv_glu_ffn(h, ffn_up[layer], ffn_conv_w[layer], ffn_down[layer])
    return rmsnorm(x, final_norm_g)
```

```cpp
#include <hip/hip_runtime.h>
#include <hip/hip_cooperative_groups.h>
#include <cstdio>
namespace cg = cooperative_groups;

#define LAS __attribute__((address_space(3)))
#define DI __device__ __forceinline__
typedef unsigned short bf16_t;
typedef short bf16x8 __attribute__((ext_vector_type(8)));
typedef short s16x4 __attribute__((ext_vector_type(4)));
typedef float f32x2 __attribute__((ext_vector_type(2)));
typedef float f32x4 __attribute__((ext_vector_type(4)));
typedef float f32x16 __attribute__((ext_vector_type(16)));
typedef unsigned u32x2 __attribute__((ext_vector_type(2)));
typedef unsigned u32x4 __attribute__((ext_vector_type(4)));
typedef __bf16 bf16v2 __attribute__((ext_vector_type(2)));

constexpr int T = 32768, SEQ = 2048, DM = 1024, DIN = 3072, DFF = 2816, DUP = 5632, NL = 2;
constexpr float EPS = 1e-6f;
constexpr int BM = 256, BK = 64, HALF = 128, HTB = HALF * BK * 2, STAGE_BYTES = 8 * HTB, NXCD = 8, WGM = 4;
constexpr int XCH_OFF = STAGE_BYTES, XB_ST_OFF = STAGE_BYTES + 2048, RST_OFF = STAGE_BYTES + 4096, LDS_BYTES = STAGE_BYTES + 4096 + 12 * 1024;
constexpr int NPHASE = 12;

constexpr size_t SZ_WIN = (size_t)DIN * DM * 2, SZ_WOUT = (size_t)DM * DM * 2, SZ_WUP = (size_t)DUP * DM * 2, SZ_WDN = (size_t)DM * DFF * 2;
constexpr size_t WS_WIN = 0, WS_WOUT = WS_WIN + NL * SZ_WIN, WS_WUP = WS_WOUT + NL * SZ_WOUT, WS_WDN = WS_WUP + NL * SZ_WUP;
constexpr size_t WS_XB = WS_WDN + NL * SZ_WDN;
constexpr size_t WS_PROJ = WS_XB + (size_t)T * DM * 2;
constexpr size_t WS_MIX = WS_PROJ + (size_t)T * DIN * 2;
constexpr size_t WS_SS = WS_MIX + (size_t)T * DM * 2;
constexpr size_t WS_H = WS_SS + (size_t)16 * T * 4;
constexpr size_t WS_BAR = WS_H + (size_t)128 * 4 * DUP * 4;
constexpr size_t WS_END = WS_BAR + 16384;

struct Params;
typedef const __attribute__((address_space(4))) Params* PP;
struct Params {
    const float* x; const float* norm1_g; const float* w_in; const float* mix_conv_w; const float* attn_out_g; const float* conv_out_g;
    const float* w_out; const float* norm2_g; const float* ffn_up; const float* ffn_conv_w; const float* ffn_down; const float* final_norm_g;
    float* out; unsigned char* ws; int ph_lo, ph_hi, coop, pad;
};

DI unsigned pk2(float a, float b) { f32x2 v = {a, b}; bf16v2 r = __builtin_convertvector(v, bf16v2); return __builtin_bit_cast(unsigned, r); }
DI float bf_lo(unsigned u) { return __uint_as_float(u << 16); }
DI float bf_hi(unsigned u) { return __uint_as_float(u & 0xffff0000u); }
DI float xor16_32(float v) { v += __shfl_xor(v, 16); v += __shfl_xor(v, 32); return v; }

__host__ __device__ __forceinline__ int lds_byte(int r, int c) { const int st = (r >> 4) * 2 + (c >> 5), rr = r & 15, cc = c & 31, ob = rr * 64 + cc * 2; return st * 1024 + (ob ^ (((ob >> 9) & 1) << 5)); }
__host__ __device__ __forceinline__ void stage_rc(int b, int& R, int& C) { const int st = b / 1024, sb = b % 1024, swz = sb ^ (((sb >> 9) & 1) << 5); R = (st >> 1) * 16 + swz / 64; C = (st & 1) * 32 + (swz % 64) / 2; }
__host__ __device__ __forceinline__ int perm32(int rho) { const int n = rho >> 4, i = rho & 15; return 8 * (i >> 2) + 4 * n + (i & 3); }

struct Unit { int pm, pn; };
struct Gemm { const bf16_t* A; const bf16_t* Bt; int M, N, K; };
struct StaticOrder {
    int nM, nN, nwg, G, c;
    DI void init(int M, int N, int G_, int c_) { nM = M / BM; nN = N / BM; nwg = nM * nN; G = G_; c = c_; }
    DI bool next(int i, Unit& u) const {
        const long L = (long)i * G + c; if (L >= nwg) return false;
        int wgid = (int)L; { const int q = nwg / NXCD, r = nwg % NXCD, xcd = wgid % NXCD, off = wgid / NXCD; wgid = (xcd < r ? xcd * (q + 1) : r * (q + 1) + (xcd - r) * q) + off; }
        const int nig = WGM * nN, gid = wgid / nig, fm = gid * WGM, gsz = (nM - fm) < WGM ? (nM - fm) : WGM;
        u.pm = fm + ((wgid % nig) % gsz); u.pn = (wgid % nig) / gsz; return true;
    }
};


DI float row_rstd(const float* ss, int row, int fq) {
    const float* p = ss + (size_t)(4 * fq) * T + row;
    float s = (p[0] + p[T]) + (p[2 * T] + p[3 * T]);
    s = xor16_32(s);
    return rsqrtf(s * (1.f / DM) + EPS);
}

struct EpiProj {
    static constexpr bool PERM = true, ROWPERM = false;
    bf16_t* O; const float* ss;
    DI void operator()(f32x4 (&acc)[2][2][4][2], const Unit& u, int wr, int wc, int fr, int fq, LAS unsigned char* lds, int ui) const {
        const int row0 = u.pm * BM + wr * 64 + fr, col0 = u.pn * BM + wc * 32 + 8 * fq;
#pragma unroll
        for (int ai = 0; ai < 2; ++ai)
#pragma unroll
            for (int m = 0; m < 4; ++m) {
                const int row = row0 + ai * HALF + m * 16; const float rs = ((const LAS float*)(lds + RST_OFF))[ui * 256 + ai * HALF + wr * 64 + m * 16 + fr];
                bf16_t* rowp = O + (size_t)row * DIN + col0;
#pragma unroll
                for (int bj = 0; bj < 2; ++bj) { const f32x4 v0 = acc[ai][bj][m][0] * rs, v1 = acc[ai][bj][m][1] * rs;
                    u32x4 w; w.x = pk2(v0[0], v0[1]); w.y = pk2(v0[2], v0[3]); w.z = pk2(v1[0], v1[1]); w.w = pk2(v1[2], v1[3]);
                    *(u32x4*)(rowp + bj * HALF) = w; }
                asm volatile("" ::: "memory");
            }
    }
};

struct EpiRes {
    static constexpr bool PERM = true, ROWPERM = false;
    bf16_t* xb; float* ss;
    DI void operator()(f32x4 (&acc)[2][2][4][2], const Unit& u, int wr, int wc, int fr, int fq, LAS unsigned char* lds, int ui) const {
        const int row0 = u.pm * BM + wr * 64 + fr, col0 = u.pn * BM + wc * 32 + 8 * fq;
#pragma unroll
        for (int ai = 0; ai < 2; ++ai) {
            u32x4 xv[4][2];
#pragma unroll
            for (int m = 0; m < 4; ++m)
#pragma unroll
                for (int bj = 0; bj < 2; ++bj) xv[m][bj] = *(const u32x4*)(xb + (size_t)(row0 + ai * HALF + m * 16) * DM + col0 + bj * HALF);
            float sq[4];
#pragma unroll
            for (int m = 0; m < 4; ++m) {
                bf16_t* rowp = xb + (size_t)(row0 + ai * HALF + m * 16) * DM + col0; float q = 0.f;
#pragma unroll
                for (int bj = 0; bj < 2; ++bj) {
                    const u32x4 x4 = xv[m][bj];
                    const f32x4 a0 = acc[ai][bj][m][0], a1 = acc[ai][bj][m][1];
                    u32x4 w; w.x = pk2(bf_lo(x4.x) + a0[0], bf_hi(x4.x) + a0[1]); w.y = pk2(bf_lo(x4.y) + a0[2], bf_hi(x4.y) + a0[3]);
                    w.z = pk2(bf_lo(x4.z) + a1[0], bf_hi(x4.z) + a1[1]); w.w = pk2(bf_lo(x4.w) + a1[2], bf_hi(x4.w) + a1[3]);
                    *(u32x4*)(rowp + bj * HALF) = w;
                    q += (bf_lo(w.x) * bf_lo(w.x) + bf_hi(w.x) * bf_hi(w.x)) + (bf_lo(w.y) * bf_lo(w.y) + bf_hi(w.y) * bf_hi(w.y))
                       + (bf_lo(w.z) * bf_lo(w.z) + bf_hi(w.z) * bf_hi(w.z)) + (bf_lo(w.w) * bf_lo(w.w) + bf_hi(w.w) * bf_hi(w.w));
                }
                sq[m] = q;
            }
#pragma unroll
            for (int m = 0; m < 4; ++m) { const float q = xor16_32(sq[m]); if (fq == 0) ss[(size_t)(u.pn * 4 + wc) * T + row0 + ai * HALF + m * 16] = q; }
            asm volatile("" ::: "memory");
        }
    }
};

DI float dpp_shr1(float v) { return __int_as_float(__builtin_amdgcn_update_dpp(0, __float_as_int(v), 0x111, 0xf, 0xf, true)); }
DI float silu_mul(float g, float v) { return g * v * __builtin_amdgcn_rcpf(1.f + __builtin_amdgcn_exp2f(-1.44269504089f * g)); }

struct EpiUp {
    static constexpr bool PERM = true, ROWPERM = true;
    bf16_t* act; const float* ss; const float* cw; float* H;
    DI void operator()(f32x4 (&acc)[2][2][4][2], const Unit& u, int wr, int wc, int fr, int fq, LAS unsigned char* lds, int ui) const {
        const int row0 = u.pm * BM + wr * 128 + fr * 8;
        const int ct = wc * 32 + 8 * fq;
        {
            float s8[8];
#pragma unroll
            for (int i = 0; i < 8; ++i) s8[i] = 0.f;
#pragma unroll
            for (int pl = 0; pl < 4; ++pl) { const float* p = ss + (size_t)(4 * fq + pl) * T + row0; const f32x4 a = *(const f32x4*)p, b = *(const f32x4*)(p + 4);
#pragma unroll
                for (int i = 0; i < 4; ++i) { s8[i] += a[i]; s8[4 + i] += b[i]; } }
#pragma unroll
            for (int i = 0; i < 8; ++i) { const float rs = rsqrtf(xor16_32(s8[i]) * (1.f / DM) + EPS);
#pragma unroll
                for (int bj = 0; bj < 2; ++bj)
#pragma unroll
                    for (int n = 0; n < 2; ++n) acc[i >> 2][bj][i & 3][n] *= rs; }
        }
        LAS float* xch = (LAS float*)(lds + XCH_OFF);
        if (fr == 0 && wr == 0) {
#pragma unroll
            for (int k = 0; k < 2; ++k)
#pragma unroll
                for (int bj = 0; bj < 2; ++bj)
#pragma unroll
                    for (int n = 0; n < 2; ++n) *(f32x4*)(H + ((size_t)u.pm * 4 + k) * DUP + u.pn * BM + bj * HALF + ct + 4 * n) = acc[0][bj][k][n];
        }
        if (fr == 15) {
            if (wr == 1) {
#pragma unroll
                for (int k = 0; k < 2; ++k)
#pragma unroll
                    for (int bj = 0; bj < 2; ++bj)
#pragma unroll
                        for (int n = 0; n < 2; ++n) *(f32x4*)(H + ((size_t)u.pm * 4 + 2 + k) * DUP + u.pn * BM + bj * HALF + ct + 4 * n) = acc[1][bj][2 + k][n];
            } else {
#pragma unroll
                for (int k = 0; k < 2; ++k)
#pragma unroll
                    for (int bj = 0; bj < 2; ++bj)
#pragma unroll
                        for (int n = 0; n < 2; ++n) *(LAS f32x4*)(xch + ((wc * 4 + fq) * 2 + k) * 16 + (bj * 2 + n) * 4) = acc[1][bj][2 + k][n];
            }
        }
        asm volatile("s_waitcnt lgkmcnt(0)" ::: "memory");
        __builtin_amdgcn_s_barrier();
        asm volatile("" ::: "memory");
        const size_t cwc = (size_t)u.pn * 128 + ct;
#pragma unroll
        for (int n = 0; n < 2; ++n) {
            f32x4 w[2][3];
#pragma unroll
            for (int bj = 0; bj < 2; ++bj)
#pragma unroll
                for (int k = 0; k < 3; ++k) w[bj][k] = *(const f32x4*)(cw + (size_t)k * DUP + bj * DFF + cwc + 4 * n);
#pragma unroll
            for (int bj = 0; bj < 2; ++bj) {
                f32x4 h1, h2;
#pragma unroll
                for (int e = 0; e < 4; ++e) { h1[e] = dpp_shr1(acc[1][bj][3][n][e]); h2[e] = dpp_shr1(acc[1][bj][2][n][e]); }
                if (fr == 0) {
                    if (wr == 1) { h2 = *(LAS f32x4*)(xch + ((wc * 4 + fq) * 2 + 0) * 16 + (bj * 2 + n) * 4); h1 = *(LAS f32x4*)(xch + ((wc * 4 + fq) * 2 + 1) * 16 + (bj * 2 + n) * 4); }
                    else { h1 = (f32x4){0.f, 0.f, 0.f, 0.f}; h2 = h1; }
                }
#pragma unroll
                for (int i = 7; i >= 0; --i) {
                    const f32x4 p0 = acc[i >> 2][bj][i & 3][n];
                    const f32x4 p1 = (i >= 1) ? acc[(i - 1) >> 2][bj][(i - 1) & 3][n] : h1;
                    const f32x4 p2 = (i >= 2) ? acc[(i - 2) >> 2][bj][(i - 2) & 3][n] : (i == 1 ? h1 : h2);
                    acc[i >> 2][bj][i & 3][n] = w[bj][2] * p0 + w[bj][1] * p1 + w[bj][0] * p2;
                }
            }
#pragma unroll
            for (int i = 0; i < 8; ++i)
#pragma unroll
                for (int e = 0; e < 4; ++e) acc[i >> 2][0][i & 3][n][e] = silu_mul(acc[i >> 2][0][i & 3][n][e], acc[i >> 2][1][i & 3][n][e]);
            asm volatile("" ::: "memory");
        }
#pragma unroll
        for (int i = 0; i < 8; ++i) { const f32x4 v0 = acc[i >> 2][0][i & 3][0], v1 = acc[i >> 2][0][i & 3][1];
            u32x4 o; o.x = pk2(v0[0], v0[1]); o.y = pk2(v0[2], v0[3]); o.z = pk2(v1[0], v1[1]); o.w = pk2(v1[2], v1[3]);
            *(u32x4*)(act + (size_t)(row0 + i) * DFF + cwc) = o; asm volatile("" ::: "memory"); }
    }
};

DI void rstd_table(LAS unsigned char* lds, const StaticOrder& S, const float* __restrict__ ss, const int tid) {
    LAS float* rt = (LAS float*)(lds + RST_OFF);
    const int row = tid & 255, par = tid >> 8;
    Unit u;
    for (int i = par; S.next(i, u); i += 2) {
        const float* p = ss + (size_t)u.pm * BM + row; float s = 0.f;
#pragma unroll
        for (int pl = 0; pl < 16; ++pl) s += p[(size_t)pl * T];
        rt[i * 256 + row] = rsqrtf(s * (1.f / DM) + EPS);
    }
    __syncthreads();
}

template <class Epi>
DI void gemm_phase(LAS unsigned char* lds, const Gemm g, const StaticOrder& S, const Epi& E, const int tid) {
    const int wid = __builtin_amdgcn_readfirstlane(tid >> 6), lane = tid & 63, wr = wid >> 2, wc = wid & 3, fr = lane & 15, fq = lane >> 4;
    const int K = g.K, nt = K / BK;
    unsigned voffA[2], voffB[2];
#pragma unroll
    for (int i = 0; i < 2; ++i) { int R, C; stage_rc(tid * 16 + i * 8192, R, C); const int Rb = Epi::PERM ? ((R & ~31) + perm32(R & 31)) : R;
        voffB[i] = (unsigned)(Rb * K + C) * 2u;
        const int Ra = Epi::ROWPERM ? (128 * (R >> 6) + 8 * (R & 15) + ((R >> 4) & 3)) : R;
        voffA[i] = (unsigned)(Ra * K + C) * 2u; }
    const size_t kstep = (size_t)(BK * 2);
    const size_t hstep = (size_t)HALF * K * 2;
    const size_t tstep = 2 * hstep;
    const size_t astep = Epi::ROWPERM ? (size_t)4 * K * 2 : hstep;
    const unsigned ldsw = (unsigned)wid * 1024u;
    const int aoff = lds_byte(wr * 64 + fr, fq * 8), boff = lds_byte(wc * 32 + fr, fq * 8);
#define PG8_SA(b, h) (((b) * 2 + (h)) * HTB)
#define PG8_SB(b, h) ((4 + (b) * 2 + (h)) * HTB)
#define PG8_STAGE(bufoff, gbase, voff) do { _Pragma("unroll") for (int _i = 0; _i < 2; ++_i) \
        __builtin_amdgcn_global_load_lds((const unsigned*)((const char*)(gbase) + (voff)[_i]), (LAS unsigned*)(lds + (bufoff) + ldsw + _i * 8192), 16, 0, 0); } while (0)
#define PG8_LDA(dst, b, h) do { _Pragma("unroll") for (int m = 0; m < 4; ++m) _Pragma("unroll") for (int k = 0; k < 2; ++k) dst[m][k] = *(const LAS bf16x8*)(lds + PG8_SA(b, h) + aoff + m * 2048 + k * 1024); } while (0)
#define PG8_LDB(dst, b, h) do { _Pragma("unroll") for (int n = 0; n < 2; ++n) _Pragma("unroll") for (int k = 0; k < 2; ++k) dst[n][k] = *(const LAS bf16x8*)(lds + PG8_SB(b, h) + boff + n * 2048 + k * 1024); } while (0)
#define PG8_MMA(ai, bj, At, Bt) do { __builtin_amdgcn_s_setprio(1); _Pragma("unroll") for (int m = 0; m < 4; ++m) _Pragma("unroll") for (int n = 0; n < 2; ++n) _Pragma("unroll") for (int k = 0; k < 2; ++k) \
        acc[ai][bj][m][n] = __builtin_amdgcn_mfma_f32_16x16x32_bf16(Bt[n][k], At[m][k], acc[ai][bj][m][n], 0, 0, 0); __builtin_amdgcn_s_setprio(0); } while (0)
#define PG8_WAIT_V(n) asm volatile("s_waitcnt vmcnt(" #n ")" ::: "memory")
#define PG8_WAIT_L(n) asm volatile("s_waitcnt lgkmcnt(" #n ")" ::: "memory")
#define PG8_BAR __builtin_amdgcn_s_barrier()
#define PG8_SCHED __builtin_amdgcn_sched_barrier(0)
    Unit cur, nxt; int ui = 0;
    if (!S.next(0, cur)) return;
    f32x4 acc[2][2][4][2];
#pragma unroll
    for (int a = 0; a < 2; ++a)
#pragma unroll
        for (int b = 0; b < 2; ++b)
#pragma unroll
            for (int m = 0; m < 4; ++m)
#pragma unroll
                for (int n = 0; n < 2; ++n) acc[a][b][m][n] = (f32x4){0.f, 0.f, 0.f, 0.f};
    bf16x8 At[4][2], B0[2][2], B1[2][2];
    const char* cA = (const char*)g.A + (size_t)cur.pm * tstep; const char* cB = (const char*)g.Bt + (size_t)cur.pn * tstep;
    PG8_STAGE(PG8_SB(0, 0), cB, voffB); PG8_STAGE(PG8_SA(0, 0), cA, voffA); PG8_STAGE(PG8_SB(0, 1), cB + hstep, voffB); PG8_STAGE(PG8_SA(0, 1), cA + astep, voffA);
    if (wr == 1) PG8_BAR;
    PG8_WAIT_V(4); PG8_BAR;
    PG8_STAGE(PG8_SB(1, 0), cB + kstep, voffB); PG8_STAGE(PG8_SA(1, 0), cA + kstep, voffA); PG8_STAGE(PG8_SB(1, 1), cB + hstep + kstep, voffB);
    PG8_WAIT_V(6); PG8_BAR;
    for (;;) {
        const bool has_next = S.next(ui + 1, nxt);
        const char* nA = has_next ? (const char*)g.A + (size_t)nxt.pm * tstep : cA; const char* nB = has_next ? (const char*)g.Bt + (size_t)nxt.pn * tstep : cB;
        for (int t = 0; t < nt; t += 2) {
            const bool last = (t == nt - 2);
            const char* a1 = cA + (size_t)(t + 1) * kstep;
            const char* a2 = last ? nA : cA + (size_t)(t + 2) * kstep; const char* b2 = last ? nB : cB + (size_t)(t + 2) * kstep;
            const char* a3 = a2 + kstep; const char* b3 = b2 + kstep;
            PG8_LDB(B0, 0, 0); PG8_SCHED; PG8_LDA(At, 0, 0); PG8_STAGE(PG8_SA(1, 1), a1 + astep, voffA);
            PG8_WAIT_L(8); PG8_BAR; PG8_WAIT_L(0); PG8_MMA(0, 0, At, B0); PG8_BAR; PG8_SCHED;
            PG8_LDB(B1, 0, 1); PG8_STAGE(PG8_SB(0, 0), b2, voffB);
            PG8_BAR; PG8_WAIT_L(0); PG8_MMA(0, 1, At, B1); PG8_BAR;
            PG8_LDA(At, 0, 1); PG8_STAGE(PG8_SA(0, 0), a2, voffA);
            PG8_BAR; PG8_WAIT_L(0); PG8_MMA(1, 0, At, B0); PG8_BAR; PG8_SCHED;
            PG8_STAGE(PG8_SB(0, 1), b2 + hstep, voffB);
            PG8_WAIT_V(6); PG8_BAR; PG8_MMA(1, 1, At, B1); PG8_BAR;
            PG8_LDB(B0, 1, 0); PG8_SCHED; PG8_LDA(At, 1, 0); PG8_STAGE(PG8_SA(0, 1), a2 + astep, voffA);
            PG8_WAIT_L(8); PG8_BAR; PG8_WAIT_L(0); PG8_MMA(0, 0, At, B0); PG8_BAR; PG8_SCHED;
            PG8_LDB(B1, 1, 1); PG8_STAGE(PG8_SB(1, 0), b3, voffB);
            PG8_BAR; PG8_WAIT_L(0); PG8_MMA(0, 1, At, B1); PG8_BAR;
            PG8_LDA(At, 1, 1); PG8_STAGE(PG8_SA(1, 0), a3, voffA);
            PG8_BAR; PG8_WAIT_L(0); PG8_MMA(1, 0, At, B0); PG8_BAR; PG8_SCHED;
            PG8_STAGE(PG8_SB(1, 1), b3 + hstep, voffB);
            PG8_WAIT_V(6); PG8_BAR; PG8_MMA(1, 1, At, B1); PG8_BAR;
        }
        { int fr2 = fr, fq2 = fq; asm volatile("" : "+v"(fr2), "+v"(fq2));
          E(acc, cur, wr, wc, fr2, fq2, lds, ui); }
        if (!has_next) break;
#pragma unroll
        for (int a = 0; a < 2; ++a)
#pragma unroll
            for (int b = 0; b < 2; ++b)
#pragma unroll
                for (int m = 0; m < 4; ++m)
#pragma unroll
                    for (int n = 0; n < 2; ++n) acc[a][b][m][n] = (f32x4){0.f, 0.f, 0.f, 0.f};
        cur = nxt; cA = nA; cB = nB; ++ui;
    }
    PG8_WAIT_V(0);
    if (wr == 0) PG8_BAR;
    PG8_BAR;
#undef PG8_SA
#undef PG8_SB
#undef PG8_STAGE
#undef PG8_LDA
#undef PG8_LDB
#undef PG8_MMA
#undef PG8_WAIT_V
#undef PG8_WAIT_L
#undef PG8_BAR
#undef PG8_SCHED
}

struct WItem { const float* W; const float* g; bf16_t* WT; int K, N, k0, n0, drow0; };
DI void transpose_load(const WItem& w, float (&v)[32], int lane) {
    const float* rb = w.W + (size_t)w.k0 * w.N + w.n0;
    const unsigned lo = (unsigned)(lane >> 5) * (unsigned)w.N + (unsigned)(lane & 31), hl = (unsigned)(lane >> 5);
    const float* gb = w.g ? w.g + w.k0 : nullptr;
#pragma unroll
    for (int i = 0; i < 32; ++i) { const float gv = gb ? gb[hl + 2u * i] : 1.f;
        v[i] = rb[lo + (unsigned)(2 * i) * (unsigned)w.N] * gv; }
}
DI void transpose_finish(const WItem& w, const float (&v)[32], LAS float* scr, int lane) {
#pragma unroll
    for (int i = 0; i < 32; ++i) scr[(2 * i + (lane >> 5)) * 33 + (lane & 31)] = v[i];
    asm volatile("s_waitcnt lgkmcnt(0)" ::: "memory");
    const int c = lane & 7;
#pragma unroll
    for (int j = 0; j < 4; ++j) { const int n = (lane >> 3) + 8 * j; const LAS float* sp = scr + (8 * c) * 33 + n;
        u32x4 o; o.x = pk2(sp[0], sp[33]); o.y = pk2(sp[2 * 33], sp[3 * 33]); o.z = pk2(sp[4 * 33], sp[5 * 33]); o.w = pk2(sp[6 * 33], sp[7 * 33]);
        *(u32x4*)(w.WT + (size_t)(w.drow0 + n) * w.K + w.k0 + 8 * c) = o; }
    asm volatile("s_waitcnt lgkmcnt(0)" ::: "memory");
}

constexpr int I_IN = 16 * 96, I_OUT = 16 * 32, I_UP = 16 * 176, I_DN = 44 * 32, I_L = I_IN + I_OUT + I_UP + I_DN;
DI WItem weight_desc(PP p, int it) {
    WItem w; const int l = it / I_L; int r = it % I_L;
    if (r < I_IN) { const int kb = r / 96, nb = r % 96;
        w.W = p->w_in + (size_t)l * DM * DIN; w.g = p->norm1_g + l * DM; w.K = DM; w.N = DIN; w.WT = (bf16_t*)(p->ws + WS_WIN + l * SZ_WIN); w.k0 = kb * 64; w.n0 = nb * 32; w.drow0 = nb * 32; return w; }
    r -= I_IN;
    if (r < I_OUT) { const int kb = r / 32, nb = r % 32;
        w.W = p->w_out + (size_t)l * DM * DM; w.g = nullptr; w.K = DM; w.N = DM; w.WT = (bf16_t*)(p->ws + WS_WOUT + l * SZ_WOUT); w.k0 = kb * 64; w.n0 = nb * 32; w.drow0 = nb * 32; return w; }
    r -= I_OUT;
    if (r < I_UP) { const int kb = r / 176, nb = r % 176; const int n0 = nb * 32;
        const int drow = (n0 < DFF) ? ((n0 / 128) * 256 + (n0 % 128)) : (((n0 - DFF) / 128) * 256 + 128 + ((n0 - DFF) % 128));
        w.W = p->ffn_up + (size_t)l * DM * DUP; w.g = p->norm2_g + l * DM; w.K = DM; w.N = DUP; w.WT = (bf16_t*)(p->ws + WS_WUP + l * SZ_WUP); w.k0 = kb * 64; w.n0 = n0; w.drow0 = drow; return w; }
    r -= I_UP;
    { const int kb = r / 32, nb = r % 32;
        w.W = p->ffn_down + (size_t)l * DFF * DM; w.g = nullptr; w.K = DFF; w.N = DM; w.WT = (bf16_t*)(p->ws + WS_WDN + l * SZ_WDN); w.k0 = kb * 64; w.n0 = nb * 32; w.drow0 = nb * 32; return w; }
}
DI void weight_item(PP p, int it, LAS float* scr, int lane) { const WItem w = weight_desc(p, it); float v[32]; transpose_load(w, v, lane); transpose_finish(w, v, scr, lane); }
DI void weight_item2(PP p, int it0, int it1, bool has1, LAS float* scr, int lane) {
    const WItem w0 = weight_desc(p, it0), w1 = weight_desc(p, has1 ? it1 : it0);
    float v0[32], v1[32];
    transpose_load(w0, v0, lane); transpose_load(w1, v1, lane);
    transpose_finish(w0, v0, scr, lane);
    if (has1) transpose_finish(w1, v1, scr, lane);
}

DI void phase_prep(PP p, LAS unsigned char* lds, const int tid) {
    const int lane = tid & 63, wave = __builtin_amdgcn_readfirstlane(tid >> 6);
    const int gw = blockIdx.x * 8 + wave, NGW = gridDim.x * 8;
    {
        bf16_t* xb = (bf16_t*)(p->ws + WS_XB); float* ss = (float*)(p->ws + WS_SS); const float* x = p->x;
        for (int row0 = gw * 4; row0 < T; row0 += NGW * 4) {
            f32x4 xa[4][2], xc[4][2];
#pragma unroll
            for (int q = 0; q < 4; ++q)
#pragma unroll
                for (int j = 0; j < 2; ++j) { const size_t o = (size_t)(row0 + q) * DM + 8 * lane + 512 * j; xa[q][j] = *(const f32x4*)(x + o); xc[q][j] = *(const f32x4*)(x + o + 4); }
#pragma unroll
            for (int q = 0; q < 4; ++q) {
                float sq = 0.f;
#pragma unroll
                for (int j = 0; j < 2; ++j) { const size_t o = (size_t)(row0 + q) * DM + 8 * lane + 512 * j; const f32x4 a = xa[q][j], b = xc[q][j];
                    u32x4 w; w.x = pk2(a[0], a[1]); w.y = pk2(a[2], a[3]); w.z = pk2(b[0], b[1]); w.w = pk2(b[2], b[3]);
                    *(u32x4*)(xb + o) = w;
                    sq += (bf_lo(w.x) * bf_lo(w.x) + bf_hi(w.x) * bf_hi(w.x)) + (bf_lo(w.y) * bf_lo(w.y) + bf_hi(w.y) * bf_hi(w.y))
                        + (bf_lo(w.z) * bf_lo(w.z) + bf_hi(w.z) * bf_hi(w.z)) + (bf_lo(w.w) * bf_lo(w.w) + bf_hi(w.w) * bf_hi(w.w)); }
#pragma unroll
                for (int o = 1; o < 64; o <<= 1) sq += __shfl_xor(sq, o);
                if (lane < 16) ss[(size_t)lane * T + row0 + q] = (lane == 0) ? sq : 0.f;
            }
        }
    }
    LAS float* scr = (LAS float*)(lds + wave * 8448);
    for (int it = gw; it < I_IN; it += NGW) weight_item(p, it, scr, lane);
}

struct KV { u32x4 k[4]; u32x4 v[4]; };
constexpr int NT = 23;
DI bool tile_desc(int tt, int p0, int& kbase, int& kstride, int& W, int& cls) {
    if (tt < 8) { kstride = 1; kbase = p0 - 128 + 32 * tt; W = 128; cls = -1; }
    else if (tt < 11) { kstride = 4; kbase = p0 - 512 + 128 * (tt - 8); W = 512; cls = 0; }
    else { kstride = 4; kbase = p0 - 640 - 128 * (tt - 11); W = 2048; cls = 1; }
    return kbase + kstride * 31 >= 0;
}
DI int next_tile(int tt, int p0) { int kb, ks, W, cls; for (++tt; tt < NT; ++tt) if (tile_desc(tt, p0, kb, ks, W, cls)) break; return tt; }
DI void load_kv_at(KV& t, const bf16_t* __restrict__ base, int h, int kbase, int kstride, int vrow0, int vch) {
#pragma unroll
    for (int i = 0; i < 4; ++i) { int vpos = kbase + kstride * (vrow0 + 8 * i); vpos = vpos < 0 ? 0 : vpos;
        const bf16_t* rp = base + (size_t)vpos * DIN + h * 64 + 8 * vch;
        t.k[i] = *(const u32x4*)(rp + 512); t.v[i] = *(const u32x4*)(rp + 1024); }
}
DI void load_kv(KV& t, const bf16_t* __restrict__ base, int h, int tt, int p0, const bf16_t* __restrict__ nbase, int nh, int np0, int vrow0, int vch) {
    const bool here = tt < NT;
    int kbase, kstride, W, cls; tile_desc(here ? tt : next_tile(-1, np0), here ? p0 : np0, kbase, kstride, W, cls);
    load_kv_at(t, here ? base : nbase, here ? h : nh, kbase, kstride, vrow0, vch);
}

struct AttnState { float mrun, lrun; f32x16 o0, o1; };

DI void attn_tile(AttnState& st, const KV& t, const bf16x8 (&qf)[4], int tt, int p0, int qpos, int r, int hh, int vrow0, int vch, LAS unsigned char* vptr, unsigned ta0, unsigned ta1, float slope2, float sc) {
    int kbase, kstride, W, cls; tile_desc(tt, p0, kbase, kstride, W, cls);
#pragma unroll
    for (int i = 0; i < 4; ++i) { const int vr = vrow0 + 8 * i;
        *(LAS u32x4*)(vptr + 4096 + vr * 128 + ((vch ^ (vr & 7)) << 4)) = t.k[i];
        *(LAS u32x4*)(vptr + vr * 128 + ((vch * 16) ^ (((vr >> 1) & 1) << 6))) = t.v[i]; }
    bf16x8 kf[4];
#pragma unroll
    for (int c = 0; c < 4; ++c) kf[c] = *(const LAS bf16x8*)(vptr + 4096 + r * 128 + (((2 * c + hh) ^ (r & 7)) << 4));
    f32x16 S;
#pragma unroll
    for (int i = 0; i < 16; ++i) S[i] = 0.f;
#pragma unroll
    for (int c = 0; c < 4; ++c) S = __builtin_amdgcn_mfma_f32_32x32x16_bf16(kf[c], qf[c], S, 0, 0, 0);
#define SC_(x) asm("" : "+v"(x))
    const float dist0 = (float)(qpos - kbase - kstride * 4 * hh), nks = -(float)kstride, nsl = -slope2;
    float sv[16];
    float tmax = -3.0e38f;
    if (cls < 0) {
        const float half = 0.5f * (float)(qpos < W ? qpos : W), dpb = dist0 - half, K0 = -slope2 * half;
        const float hq = 0.5f * (float)qpos;
        const int e3 = (r - hh) & 3; const bool pe0 = e3 == 0, pe2 = e3 == 2;
#pragma unroll
        for (int i = 0; i < 16; ++i) { const float cf = (float)((i & 3) + 8 * (i >> 2));
            float dp = __builtin_fmaf(nks, cf, dpb);
            SC_(dp);
            float sx = __builtin_fmaf(S[i], sc, __builtin_fmaf(dp, nsl, K0));
            const bool v1 = __builtin_fabsf(dp) <= half;
            if ((i & 3) == 0) {
                const bool v4 = __builtin_fabsf(dp + (half - hq)) <= hq;
                const bool v16 = (((i >> 2) & 1) ? pe2 : pe0) && v4;
                const float add = v1 ? (v16 ? 1.5849625f : 1.f) : (v16 ? 1.f : 0.f);
                sx = v4 ? sx + add : -3.0e38f;
            } else sx = v1 ? sx : -3.0e38f;
            SC_(sx);
            sv[i] = sx; tmax = fmaxf(tmax, sx); }
    } else {
        const float hA = (cls == 0) ? 0.5f * (float)(qpos < 512 ? qpos : 512) : -1.f;
        const float hB = 0.5f * (float)qpos;
        const int rc = r & 3;
#pragma unroll
        for (int i = 0; i < 16; ++i) { const float cf = (float)((i & 3) + 8 * (i >> 2));
            float dist = __builtin_fmaf(nks, cf, dist0);
            SC_(dist);
            const bool vA = __builtin_fabsf(dist - hA) <= hA;
            const bool vB = (rc == (i & 3)) && (__builtin_fabsf(dist - hB) <= hB);
            float sx = __builtin_fmaf(S[i], sc, dist * nsl);
            sx += (vA && vB) ? 1.f : 0.f;
            sx = (vA || vB) ? sx : -3.0e38f;
            SC_(sx);
            sv[i] = sx; tmax = fmaxf(tmax, sx); }
    }
    s16x4 t0, t1, t2, t3, t4, t5, t6, t7;
    asm volatile("s_waitcnt lgkmcnt(0)\n\t"
                 "ds_read_b64_tr_b16 %0, %8\n\tds_read_b64_tr_b16 %1, %8 offset:1024\n\tds_read_b64_tr_b16 %2, %8 offset:2048\n\tds_read_b64_tr_b16 %3, %8 offset:3072\n\t"
                 "ds_read_b64_tr_b16 %4, %9\n\tds_read_b64_tr_b16 %5, %9 offset:1024\n\tds_read_b64_tr_b16 %6, %9 offset:2048\n\tds_read_b64_tr_b16 %7, %9 offset:3072"
                 : "=&v"(t0), "=&v"(t1), "=&v"(t2), "=&v"(t3), "=&v"(t4), "=&v"(t5), "=&v"(t6), "=&v"(t7) : "v"(ta0), "v"(ta1) : "memory");
    if (__builtin_amdgcn_ballot_w64(tmax > st.mrun + 8.f) != 0ull) {
        tmax = fmaxf(tmax, __shfl_xor(tmax, 32));
        const float mnew = fmaxf(st.mrun, tmax), alpha = __builtin_amdgcn_exp2f(st.mrun - mnew); st.mrun = mnew;
        st.lrun *= alpha;
#pragma unroll
        for (int i = 0; i < 16; ++i) { float a0 = st.o0[i] * alpha, a1 = st.o1[i] * alpha; SC_(a0); SC_(a1); st.o0[i] = a0; st.o1[i] = a1; }
    }
    const float mn = st.mrun;
    float psum = 0.f;
#pragma unroll
    for (int i = 0; i < 16; ++i) { float e = sv[i] - mn; SC_(e); float pv = __builtin_amdgcn_exp2f(e); SC_(pv); S[i] = pv; psum += pv; }
    st.lrun += psum;
#undef SC_
    bf16x8 pf[2];
#pragma unroll
    for (int s = 0; s < 2; ++s) { u32x4 w; w.x = pk2(S[8 * s], S[8 * s + 1]); w.y = pk2(S[8 * s + 2], S[8 * s + 3]); w.z = pk2(S[8 * s + 4], S[8 * s + 5]); w.w = pk2(S[8 * s + 6], S[8 * s + 7]);
        pf[s] = __builtin_bit_cast(bf16x8, w); }
    asm volatile("s_waitcnt lgkmcnt(0)" : "+v"(t0), "+v"(t1), "+v"(t2), "+v"(t3), "+v"(t4), "+v"(t5), "+v"(t6), "+v"(t7) :: "memory");
    const bf16x8 v00 = __builtin_shufflevector(t0, t1, 0, 1, 2, 3, 4, 5, 6, 7), v01 = __builtin_shufflevector(t2, t3, 0, 1, 2, 3, 4, 5, 6, 7);
    const bf16x8 v10 = __builtin_shufflevector(t4, t5, 0, 1, 2, 3, 4, 5, 6, 7), v11 = __builtin_shufflevector(t6, t7, 0, 1, 2, 3, 4, 5, 6, 7);
    st.o0 = __builtin_amdgcn_mfma_f32_32x32x16_bf16(v00, pf[0], st.o0, 0, 0, 0);
    st.o0 = __builtin_amdgcn_mfma_f32_32x32x16_bf16(v01, pf[1], st.o0, 0, 0, 0);
    st.o1 = __builtin_amdgcn_mfma_f32_32x32x16_bf16(v10, pf[0], st.o1, 0, 0, 0);
    st.o1 = __builtin_amdgcn_mfma_f32_32x32x16_bf16(v11, pf[1], st.o1, 0, 0, 0);
}

DI void attn_item(const bf16_t* __restrict__ proj, bf16_t* __restrict__ mixed, const LAS float* ogl, unsigned vlds, LAS unsigned char* vptr, int b, int h, int p0,
                  int nb, int nh, int np0, KV& ta, bf16x8 (&qf)[4], int lane) {
    const int r = lane & 31, hh = lane >> 5;
    const bf16_t* base = proj + (size_t)b * SEQ * DIN; const bf16_t* nbase = proj + (size_t)nb * SEQ * DIN;
    const int qpos = p0 + 4 * r;
    AttnState st; st.mrun = -1e30f; st.lrun = 0.f;
#pragma unroll
    for (int i = 0; i < 16; ++i) { st.o0[i] = 0.f; st.o1[i] = 0.f; }
    const float slope2 = __builtin_amdgcn_exp2f(-(float)(h + 1)) * 1.44269504089f;
    const float sc = 0.125f * 1.44269504089f;
    const int i16 = lane & 15, tq = i16 >> 2, tp = i16 & 3, gsub = (lane >> 4) & 1;
    const unsigned ta0 = vlds + (unsigned)((4 * hh + tq) * 128 + ((32 * gsub + 8 * tp) ^ (64 * ((tq >> 1) & 1))));
    const unsigned ta1 = ta0 ^ 64u;
    const int vrow0 = lane >> 3, vch = lane & 7;
    KV tb;
    int cur = next_tile(-1, p0);
    bool in_tb;
    for (;;) {
        int nxt = next_tile(cur, p0);
        load_kv(tb, base, h, nxt, p0, nbase, nh, np0, vrow0, vch);
        attn_tile(st, ta, qf, cur, p0, qpos, r, hh, vrow0, vch, vptr, ta0, ta1, slope2, sc);
        if (nxt >= NT) { in_tb = true; break; }
        cur = nxt; nxt = next_tile(cur, p0);
        load_kv(ta, base, h, nxt, p0, nbase, nh, np0, vrow0, vch);
        attn_tile(st, tb, qf, cur, p0, qpos, r, hh, vrow0, vch, vptr, ta0, ta1, slope2, sc);
        if (nxt >= NT) { in_tb = false; break; }
        cur = nxt;
    }
    { const int nq = np0 + 4 * r;
#pragma unroll
      for (int c = 0; c < 4; ++c) qf[c] = *(const bf16x8*)(nbase + (size_t)nq * DIN + nh * 64 + 16 * c + 8 * hh); }
    float lrun = st.lrun + __shfl_xor(st.lrun, 32);
    const float inv = 1.f / lrun;
    float ssq = 0.f;
#pragma unroll
    for (int i = 0; i < 16; ++i) { st.o0[i] *= inv; st.o1[i] *= inv; ssq += st.o0[i] * st.o0[i] + st.o1[i] * st.o1[i]; }
    ssq += __shfl_xor(ssq, 32);
    const float rstd = rsqrtf(ssq * (1.f / 64.f) + EPS);
    bf16_t* orow = mixed + ((size_t)b * SEQ + qpos) * DM + h * 64;
#pragma unroll
    for (int gi = 0; gi < 4; ++gi) { const int d0 = 8 * gi + 4 * hh;
        const f32x4 g0 = *(const LAS f32x4*)(ogl + h * 64 + d0), g1 = *(const LAS f32x4*)(ogl + h * 64 + 32 + d0);
        u32x2 w0, w1;
        w0.x = pk2(st.o0[4 * gi] * rstd * g0[0], st.o0[4 * gi + 1] * rstd * g0[1]); w0.y = pk2(st.o0[4 * gi + 2] * rstd * g0[2], st.o0[4 * gi + 3] * rstd * g0[3]);
        w1.x = pk2(st.o1[4 * gi] * rstd * g1[0], st.o1[4 * gi + 1] * rstd * g1[1]); w1.y = pk2(st.o1[4 * gi + 2] * rstd * g1[2], st.o1[4 * gi + 3] * rstd * g1[3]);
        *(u32x2*)(orow + d0) = w0; *(u32x2*)(orow + 32 + d0) = w1; }
    if (in_tb) ta = tb;
}

DI void unpack8(const u32x4 v, float (&f)[8]) { f[0] = bf_lo(v.x); f[1] = bf_hi(v.x); f[2] = bf_lo(v.y); f[3] = bf_hi(v.y); f[4] = bf_lo(v.z); f[5] = bf_hi(v.z); f[6] = bf_lo(v.w); f[7] = bf_hi(v.w); }

DI void phase_mixer(PP p, int layer, LAS unsigned char* lds, const int tid) {
    const int lane = tid & 63, wave = __builtin_amdgcn_readfirstlane(tid >> 6);
    const bf16_t* proj = (const bf16_t*)(p->ws + WS_PROJ); bf16_t* mixed = (bf16_t*)(p->ws + WS_MIX);
    const int G = gridDim.x, bid = blockIdx.x;
    const int vB = (G % 8 == 0) ? ((bid % 8) * (G / 8) + bid / 8) : bid;
    {
        const float* cw = p->mix_conv_w + (size_t)layer * 3 * 512; const float* cg_ = p->conv_out_g + (size_t)layer * 512;
        const int ch0 = 8 * lane; const int NW = G * 8, gw = vB * 8 + wave; const int per = T / NW;
        float w0[8], w1[8], w2[8], gg[8];
#pragma unroll
        for (int i = 0; i < 8; ++i) { w0[i] = cw[ch0 + i]; w1[i] = cw[512 + ch0 + i]; w2[i] = cw[1024 + ch0 + i]; gg[i] = cg_[ch0 + i]; }
        const int t0 = gw * per;
        float p1[8], p2[8];
#pragma unroll
        for (int i = 0; i < 8; ++i) { p1[i] = 0.f; p2[i] = 0.f; }
        if ((t0 % SEQ) != 0) {
            float a[8], c[8];
            unpack8(*(const u32x4*)(proj + (size_t)(t0 - 2) * DIN + 2048 + ch0), a); unpack8(*(const u32x4*)(proj + (size_t)(t0 - 2) * DIN + 2560 + ch0), c);
#pragma unroll
            for (int i = 0; i < 8; ++i) p2[i] = a[i] * c[i];
            unpack8(*(const u32x4*)(proj + (size_t)(t0 - 1) * DIN + 2048 + ch0), a); unpack8(*(const u32x4*)(proj + (size_t)(t0 - 1) * DIN + 2560 + ch0), c);
#pragma unroll
            for (int i = 0; i < 8; ++i) p1[i] = a[i] * c[i];
        }
        for (int t = t0; t < t0 + per; t += 4) {
            u32x4 rb[4], ra[4], rc[4];
#pragma unroll
            for (int q = 0; q < 4; ++q) { const bf16_t* pr = proj + (size_t)(t + q) * DIN + ch0; rb[q] = *(const u32x4*)(pr + 1536); ra[q] = *(const u32x4*)(pr + 2048); rc[q] = *(const u32x4*)(pr + 2560); }
#pragma unroll
            for (int q = 0; q < 4; ++q) {
                float gb[8], a[8], c[8], y[8];
                unpack8(rb[q], gb); unpack8(ra[q], a); unpack8(rc[q], c);
                float sq = 0.f;
#pragma unroll
                for (int i = 0; i < 8; ++i) { const float cu = a[i] * c[i]; y[i] = gb[i] * (w0[i] * p2[i] + w1[i] * p1[i] + w2[i] * cu); p2[i] = p1[i]; p1[i] = cu; sq += y[i] * y[i]; }
                sq += __shfl_xor(sq, 1); sq += __shfl_xor(sq, 2); sq += __shfl_xor(sq, 4);
                const float rs = rsqrtf(sq * (1.f / 64.f) + EPS);
                u32x4 o; o.x = pk2(y[0] * rs * gg[0], y[1] * rs * gg[1]); o.y = pk2(y[2] * rs * gg[2], y[3] * rs * gg[3]); o.z = pk2(y[4] * rs * gg[4], y[5] * rs * gg[5]); o.w = pk2(y[6] * rs * gg[6], y[7] * rs * gg[7]);
                *(u32x4*)(mixed + (size_t)(t + q) * DM + 512 + ch0) = o;
            }
        }
    }
    {
        const float* og = p->attn_out_g + (size_t)layer * 512;
        LAS float* ogl = (LAS float*)(lds + RST_OFF);
        ogl[tid] = og[tid]; __syncthreads();
        LAS unsigned char* vptr = lds + wave * 8192; const unsigned vlds = (unsigned)(size_t)vptr;
        if (G == 256) {
            const int xcd = vB / 32, wl = (vB % 32) * 8 + wave;
            LAS float* scr = (LAS float*)(lds + 65536 + wave * 8448); const int gw = bid * 8 + wave; int wit = I_IN + gw;
            KV ta; bf16x8 qf[4];
            { const int bh = xcd * 16 + wl / 64, c = wl % 64, p0 = 128 * (c >> 2) + (c & 3);
              const bf16_t* base = proj + (size_t)(bh >> 3) * SEQ * DIN; const int r = lane & 31, hh = lane >> 5;
#pragma unroll
              for (int cc = 0; cc < 4; ++cc) qf[cc] = *(const bf16x8*)(base + (size_t)(p0 + 4 * r) * DIN + (bh & 7) * 64 + 16 * cc + 8 * hh);
              int kb, ks, W, cls; tile_desc(next_tile(-1, p0), p0, kb, ks, W, cls); load_kv_at(ta, base, bh & 7, kb, ks, lane >> 3, lane & 7); }
            for (int k = 0; k < 4; ++k) {
                const int bh = xcd * 16 + k * 4 + wl / 64, c = (wl % 64 + 16 * k) % 64;
                const int kn = k < 3 ? k + 1 : k, nbh = xcd * 16 + kn * 4 + wl / 64, nc = (wl % 64 + 16 * kn) % 64;
                attn_item(proj, mixed, ogl, vlds, vptr, bh >> 3, bh & 7, 128 * (c >> 2) + (c & 3), nbh >> 3, nbh & 7, 128 * (nc >> 2) + (nc & 3), ta, qf, lane);
                if (layer == 0 && wit < NL * I_L) { weight_item2(p, wit, wit + G * 8, wit + G * 8 < NL * I_L, scr, lane); wit += 2 * G * 8; }
            }
        }
    }
}

DI void fixup_tile(PP p, int layer, const int tid, const int pm) {
    if ((pm & 7) == 0) return;
    const float* H = (const float*)(p->ws + WS_H); bf16_t* act = (bf16_t*)(p->ws + WS_PROJ); const float* cw = p->ffn_conv_w + (size_t)layer * 3 * DUP;
    const float* Hc = H + (size_t)pm * 4 * DUP; const float* Hp = H + (size_t)(pm - 1) * 4 * DUP;
    for (int idx = tid; idx < 2 * DFF; idx += 512) {
        const int i = idx / DFF, c = idx % DFF;
        const int gcol = (c >> 7) * 256 + (c & 127), vcol = gcol + 128;
        float g0, g1, g2, v0, v1, v2;
        if (i == 0) { g0 = Hc[gcol]; g1 = Hp[3 * DUP + gcol]; g2 = Hp[2 * DUP + gcol]; v0 = Hc[vcol]; v1 = Hp[3 * DUP + vcol]; v2 = Hp[2 * DUP + vcol]; }
        else { g0 = Hc[DUP + gcol]; g1 = Hc[gcol]; g2 = Hp[3 * DUP + gcol]; v0 = Hc[DUP + vcol]; v1 = Hc[vcol]; v2 = Hp[3 * DUP + vcol]; }
        const float yg = cw[2 * DUP + c] * g0 + cw[DUP + c] * g1 + cw[c] * g2;
        const float yv = cw[2 * DUP + DFF + c] * v0 + cw[DUP + DFF + c] * v1 + cw[DFF + c] * v2;
        const float a = silu_mul(yg, yv);
        const unsigned pk = pk2(a, a);
        act[(size_t)(pm * 256 + i) * DFF + c] = (bf16_t)(pk & 0xffffu);
    }
}

DI void phase_final(PP p, const int tid) {
    const int lane = tid & 63, wave = tid >> 6; const float* ss = (const float*)(p->ws + WS_SS); const bf16_t* xb = (const bf16_t*)(p->ws + WS_XB);
    f32x4 g[4];
#pragma unroll
    for (int j = 0; j < 2; ++j) { g[2 * j] = *(const f32x4*)(p->final_norm_g + 8 * lane + 512 * j); g[2 * j + 1] = *(const f32x4*)(p->final_norm_g + 8 * lane + 512 * j + 4); }
    for (int row0 = (blockIdx.x * 8 + wave) * 4; row0 < T; row0 += gridDim.x * 8 * 4) {
        u32x4 xv[4][2]; float sr[4];
#pragma unroll
        for (int q = 0; q < 4; ++q) {
#pragma unroll
            for (int j = 0; j < 2; ++j) xv[q][j] = *(const u32x4*)(xb + (size_t)(row0 + q) * DM + 8 * lane + 512 * j);
            float s = 0.f;
#pragma unroll
            for (int pl = 0; pl < 16; ++pl) s += ss[(size_t)pl * T + row0 + q];
            sr[q] = rsqrtf(s * (1.f / DM) + EPS);
        }
#pragma unroll
        for (int q = 0; q < 4; ++q)
#pragma unroll
            for (int j = 0; j < 2; ++j) { const size_t o = (size_t)(row0 + q) * DM + 8 * lane + 512 * j; const u32x4 x4 = xv[q][j]; const float rs = sr[q];
                f32x4 v0 = {bf_lo(x4.x), bf_hi(x4.x), bf_lo(x4.y), bf_hi(x4.y)}, v1 = {bf_lo(x4.z), bf_hi(x4.z), bf_lo(x4.w), bf_hi(x4.w)};
                *(f32x4*)(p->out + o) = v0 * rs * g[2 * j]; *(f32x4*)(p->out + o + 4) = v1 * rs * g[2 * j + 1]; }
    }
}

#define XB_TMO      128
#define XB_XCNT(j)  (256  + 64 * (j))
#define XB_XSUB(j)  (1280 + 64 * (j))
#define XB_XGEN(j)  (2304 + 64 * (j))
#define XB_TOP      3328
#define XB_TOPGEN   3392
#define XCD_BAR_WORDS 3456
#define XB_SPIN_CAP (1u << 18)
DI unsigned xb_ld(unsigned* p)              { return __hip_atomic_load(p, __ATOMIC_RELAXED, __HIP_MEMORY_SCOPE_AGENT); }
DI unsigned xb_add(unsigned* p, unsigned v) { return __hip_atomic_fetch_add(p, v, __ATOMIC_RELAXED, __HIP_MEMORY_SCOPE_AGENT); }
DI unsigned xb_xcc_id() { return (unsigned)__builtin_amdgcn_s_getreg((3 << 11) | 20) & 0xFu; }
#define XB_SPIN(cond, bar) do { unsigned _sp = 0; while (cond) { __builtin_amdgcn_s_sleep(1); \
    if ((++_sp & 255u) == 0u) { if (xb_ld(&(bar)[XB_TMO])) break; if (_sp > XB_SPIN_CAP) { atomicAdd(&(bar)[XB_TMO], 1u); break; } } } } while (0)
struct XcdBarrier { unsigned* bar; unsigned x; volatile LAS unsigned* st; };
DI XcdBarrier xcd_barrier_post(unsigned* bar, volatile LAS unsigned* st) {
    XcdBarrier b; b.bar = bar; b.x = xb_xcc_id(); b.st = st;
    if (threadIdx.x == 0) (void)xb_add(&bar[XB_XCNT(b.x)], 1u);
    return b;
}
DI void xcd_barrier_complete(unsigned* bar, unsigned x, unsigned& nloc, unsigned& nx) {
    const unsigned G = gridDim.x * gridDim.y * gridDim.z;
    unsigned sum, cnt, mine, sp = 0u;
    for (;;) {
        sum = 0u; cnt = 0u; mine = 0u;
#pragma unroll
        for (unsigned j = 0; j < 16; ++j) { const unsigned c = xb_ld(&bar[XB_XCNT(j)]); sum += c; cnt += (c > 0u) ? 1u : 0u; mine = (j == x) ? c : mine; }
        if (sum == G) break;
        __builtin_amdgcn_s_sleep(1);
        if ((++sp & 255u) == 0u) { if (xb_ld(&bar[XB_TMO])) break; if (sp > XB_SPIN_CAP) { atomicAdd(&bar[XB_TMO], 1u); break; } }
    }
    nloc = mine > 0u ? mine : 1u; nx = cnt > 0u ? cnt : 1u;
}
DI void xcd_barrier(const XcdBarrier& b, const int tid) {
    asm volatile("s_waitcnt vmcnt(0)" ::: "memory");
    __syncthreads();
    if (tid == 0) {
        unsigned* bar = b.bar; asm volatile("" : "+s"(bar));
        __builtin_amdgcn_s_waitcnt(0);
        unsigned nloc = b.st[0], nx = b.st[1];
        if (nloc == 0u) { xcd_barrier_complete(bar, b.x, nloc, nx); b.st[0] = nloc; b.st[1] = nx; }
        const unsigned old = xb_add(&bar[XB_XSUB(b.x)], 1u);
        const unsigned gen = old / nloc;
        if (old + 1u == (gen + 1u) * nloc) {
            __builtin_amdgcn_fence(__ATOMIC_RELEASE, "agent");
            asm volatile("s_waitcnt vmcnt(0)" ::: "memory");
            const unsigned og = xb_add(&bar[XB_TOP], 1u);
            const unsigned tg = og / nx;
            if (og + 1u == (tg + 1u) * nx) xb_add(&bar[XB_TOPGEN], 1u);
            else XB_SPIN(xb_ld(&bar[XB_TOPGEN]) == tg, bar);
            __builtin_amdgcn_fence(__ATOMIC_ACQUIRE, "agent");
            xb_add(&bar[XB_XGEN(b.x)], 1u);
            asm volatile("s_waitcnt vmcnt(0)" ::: "memory");
        } else {
            XB_SPIN(xb_ld(&bar[XB_XGEN(b.x)]) == gen, bar);
            __builtin_amdgcn_fence(__ATOMIC_ACQUIRE, "agent");
            asm volatile("s_waitcnt vmcnt(0)" ::: "memory");
        }
    }
    __syncthreads();
}

__global__ __launch_bounds__(512, 2) void fwd_kernel(Params parg) {
    extern __shared__ __attribute__((aligned(16))) unsigned char shm[];
    LAS unsigned char* lds = (LAS unsigned char*)shm;
    const int ph_lo = parg.ph_lo, ph_hi = parg.ph_hi, coop = parg.coop;
    const int wave_id = __builtin_amdgcn_readfirstlane((int)(threadIdx.x >> 6));
    volatile LAS unsigned* xst = (volatile LAS unsigned*)(lds + XB_ST_OFF);
    if (threadIdx.x == 0) { xst[0] = 0u; xst[1] = 0u; xst[2] = 0u; xst[3] = 0u; }
    __syncthreads();
    XcdBarrier xb_; xb_.bar = (unsigned*)(parg.ws + WS_BAR); xb_.x = 0; xb_.st = xst;
    if (coop == 1) xb_ = xcd_barrier_post((unsigned*)(parg.ws + WS_BAR), xst);
#ifdef PROBE_REP
    for (int ph2 = ph_lo; ph2 < ph_hi + 1; ++ph2) {
        const int ph = ph2 <= PROBE_REP ? ph2 : ph2 - 1;
#else
    for (int ph = ph_lo; ph < ph_hi; ++ph) {
#endif
        int wv_ = wave_id; asm volatile("" : "+s"(wv_));
        int tid = wv_ * 64 + (int)__builtin_amdgcn_mbcnt_hi(~0u, __builtin_amdgcn_mbcnt_lo(~0u, 0u)); asm volatile("" : "+v"(tid));
        PP p = (PP)__builtin_amdgcn_kernarg_segment_ptr(); asm volatile("" : "+s"(p));
        unsigned char* ws = p->ws;
        bf16_t* xb = (bf16_t*)(ws + WS_XB); float* ss = (float*)(ws + WS_SS);
        StaticOrder S;
        if (ph == 0) phase_prep(p, lds, tid);
        else if (ph == NPHASE - 1) phase_final(p, tid);
        else {
            const int layer = (ph - 1) / 5, sub = (ph - 1) % 5;
            if (sub == 0) {
                Gemm g; g.A = xb; g.Bt = (const bf16_t*)(ws + WS_WIN + layer * SZ_WIN); g.M = T; g.N = DIN; g.K = DM;
                EpiProj E; E.O = (bf16_t*)(ws + WS_PROJ); E.ss = ss;
                S.init(g.M, g.N, (int)gridDim.x, (int)blockIdx.x);
                rstd_table(lds, S, ss, tid);
                gemm_phase<EpiProj>(lds, g, S, E, tid);
            } else if (sub == 1) {
                phase_mixer(p, layer, lds, tid);
            } else if (sub == 2 || sub == 4) {
                Gemm g; g.M = T; g.N = DM;
                if (sub == 2) { g.A = (const bf16_t*)(ws + WS_MIX); g.Bt = (const bf16_t*)(ws + WS_WOUT + layer * SZ_WOUT); g.K = DM; }
                else { g.A = (const bf16_t*)(ws + WS_PROJ); g.Bt = (const bf16_t*)(ws + WS_WDN + layer * SZ_WDN); g.K = DFF; }
                EpiRes E; E.xb = xb; E.ss = ss;
                S.init(g.M, g.N, (int)gridDim.x, (int)blockIdx.x);
                if (sub == 4) {
                    Unit u; for (int i = 0; S.next(i, u); ++i) fixup_tile(p, layer, tid, u.pm);
                    asm volatile("s_waitcnt vmcnt(0)" ::: "memory"); __syncthreads();
                }
                gemm_phase<EpiRes>(lds, g, S, E, tid);
            } else {
                Gemm g; g.A = xb; g.Bt = (const bf16_t*)(ws + WS_WUP + layer * SZ_WUP); g.M = T; g.N = DUP; g.K = DM;
                EpiUp E; E.act = (bf16_t*)(ws + WS_PROJ); E.ss = ss; E.cw = p->ffn_conv_w + (size_t)layer * 3 * DUP; E.H = (float*)(ws + WS_H);
                S.init(g.M, g.N, (int)gridDim.x, (int)blockIdx.x);
                gemm_phase<EpiUp>(lds, g, S, E, tid);
            }
        }
#ifdef PROBE_REP
        if (ph2 < ph_hi) { if (coop == 1) xcd_barrier(xb_, tid); else if (coop == 2) cg::this_grid().sync(); }
#else
        if (ph + 1 < ph_hi) { if (coop == 1) xcd_barrier(xb_, tid); else if (coop == 2) cg::this_grid().sync(); }
#endif
    }
}

extern "C" void kernel_launch(void* const* d_in, const int* in_sizes, int n_in, void* d_out, int out_size, void* d_ws, size_t ws_size, hipStream_t stream) {
    static int grid = 0;
    if (grid == 0) {
        if (n_in != 12 || out_size != T * DM || ws_size < WS_END) { fprintf(stderr, "kernel_launch: unexpected shapes (n_in %d out %d ws %zu need %zu)\n", n_in, out_size, ws_size, (size_t)WS_END); grid = -1; return; }
        int dev = 0, cus = 0, per_cu = 0;
        (void)hipGetDevice(&dev); (void)hipDeviceGetAttribute(&cus, hipDeviceAttributeMultiprocessorCount, dev);
        if (hipFuncSetAttribute((const void*)fwd_kernel, hipFuncAttributeMaxDynamicSharedMemorySize, LDS_BYTES) != hipSuccess) { fprintf(stderr, "hipFuncSetAttribute failed\n"); grid = -1; return; }
        (void)hipOccupancyMaxActiveBlocksPerMultiprocessor(&per_cu, (const void*)fwd_kernel, 512, LDS_BYTES);
        if (per_cu < 1) per_cu = 1;
        (void)hipGetLastError();
        grid = cus;
    }
    if (grid < 0) return;
    Params p{};
    p.x = (const float*)d_in[0]; p.norm1_g = (const float*)d_in[1]; p.w_in = (const float*)d_in[2]; p.mix_conv_w = (const float*)d_in[3];
    p.attn_out_g = (const float*)d_in[4]; p.conv_out_g = (const float*)d_in[5]; p.w_out = (const float*)d_in[6]; p.norm2_g = (const float*)d_in[7];
    p.ffn_up = (const float*)d_in[8]; p.ffn_conv_w = (const float*)d_in[9]; p.ffn_down = (const float*)d_in[10]; p.final_norm_g = (const float*)d_in[11];
    p.out = (float*)d_out; p.ws = (unsigned char*)d_ws; p.pad = 0;
#if defined(MULTI_LAUNCH)
    for (int ph = 0; ph < NPHASE; ++ph) { p.ph_lo = ph; p.ph_hi = ph + 1; p.coop = 0;
        hipLaunchKernelGGL(fwd_kernel, dim3(grid), dim3(512), LDS_BYTES, stream, p); }
#else
    p.ph_lo = 0; p.ph_hi = NPHASE; p.coop = 1;
    if (hipMemsetAsync((char*)d_ws + WS_BAR, 0, 16384, stream) != hipSuccess) { fprintf(stderr, "memset of barrier words failed\n"); return; }
    void* args[] = {&p};
    hipError_t e = hipLaunchCooperativeKernel((const void*)fwd_kernel, dim3(grid), dim3(512), args, LDS_BYTES, stream);
    if (e != hipSuccess) fprintf(stderr, "cooperative launch failed: %s (grid %d)\n", hipGetErrorString(e), grid);
#endif
}
```

```cpp
#include <hip/hip_runtime.h>
#include <hip/hip_cooperative_groups.h>
#include <cstdio>
namespace cg = cooperative_groups;

#define LAS __attribute__((address_space(3)))
#define DI __device__ __forceinline__
typedef unsigned short bf16_t;
typedef short bf16x8 __attribute__((ext_vector_type(8)));
typedef short s16x4 __attribute__((ext_vector_type(4)));
typedef float f32x2 __attribute__((ext_vector_type(2)));
typedef float f32x4 __attribute__((ext_vector_type(4)));
typedef float f32x16 __attribute__((ext_vector_type(16)));
typedef unsigned u32x2 __attribute__((ext_vector_type(2)));
typedef unsigned u32x4 __attribute__((ext_vector_type(4)));
typedef __bf16 bf16v2 __attribute__((ext_vector_type(2)));

constexpr int T = 32768, SEQ = 2048, DM = 1024, DIN = 3072, DFF = 2816, DUP = 5632, NL = 2;
constexpr float EPS = 1e-6f;
constexpr int BM = 256, BK = 64, HALF = 128, HTB = HALF * BK * 2, STAGE_BYTES = 8 * HTB, NXCD = 8, WGM = 4;
constexpr int XCH_OFF = STAGE_BYTES, XB_ST_OFF = STAGE_BYTES + 2048, RST_OFF = STAGE_BYTES + 4096, LDS_BYTES = STAGE_BYTES + 4096 + 12 * 1024;
constexpr int NPHASE = 12;

constexpr size_t SZ_WIN = (size_t)DIN * DM * 2, SZ_WOUT = (size_t)DM * DM * 2, SZ_WUP = (size_t)DUP * DM * 2, SZ_WDN = (size_t)DM * DFF * 2;
constexpr size_t WS_WIN = 0, WS_WOUT = WS_WIN + NL * SZ_WIN, WS_WUP = WS_WOUT + NL * SZ_WOUT, WS_WDN = WS_WUP + NL * SZ_WUP;
constexpr size_t WS_XB = WS_WDN + NL * SZ_WDN;
constexpr size_t WS_PROJ = WS_XB + (size_t)T * DM * 2;
constexpr size_t WS_MIX = WS_PROJ + (size_t)T * DIN * 2;
constexpr size_t WS_SS = WS_MIX + (size_t)T * DM * 2;
constexpr size_t WS_H = WS_SS + (size_t)16 * T * 4;
constexpr size_t WS_BAR = WS_H + (size_t)128 * 4 * DUP * 4;
constexpr size_t WS_END = WS_BAR + 16384;

struct Params;
typedef const __attribute__((address_space(4))) Params* PP;
struct Params {
    const float* x; const float* norm1_g; const float* w_in; const float* mix_conv_w; const float* attn_out_g; const float* conv_out_g;
    const float* w_out; const float* norm2_g; const float* ffn_up; const float* ffn_conv_w; const float* ffn_down; const float* final_norm_g;
    float* out; unsigned char* ws; int ph_lo, ph_hi, coop, pad;
};

DI unsigned pk2(float a, float b) { f32x2 v = {a, b}; bf16v2 r = __builtin_convertvector(v, bf16v2); return __builtin_bit_cast(unsigned, r); }
DI float bf_lo(unsigned u) { return __uint_as_float(u << 16); }
DI float bf_hi(unsigned u) { return __uint_as_float(u & 0xffff0000u); }
DI float xor16_32(float v) { v += __shfl_xor(v, 16); v += __shfl_xor(v, 32); return v; }

__host__ __device__ __forceinline__ int lds_byte(int r, int c) { const int st = (r >> 4) * 2 + (c >> 5), rr = r & 15, cc = c & 31, ob = rr * 64 + cc * 2; return st * 1024 + (ob ^ (((ob >> 9) & 1) << 5)); }
__host__ __device__ __forceinline__ void stage_rc(int b, int& R, int& C) { const int st = b / 1024, sb = b % 1024, swz = sb ^ (((sb >> 9) & 1) << 5); R = (st >> 1) * 16 + swz / 64; C = (st & 1) * 32 + (swz % 64) / 2; }
__host__ __device__ __forceinline__ int perm32(int rho) { const int n = rho >> 4, i = rho & 15; return 8 * (i >> 2) + 4 * n + (i & 3); }

struct Unit { int pm, pn; };
struct Gemm { const bf16_t* A; const bf16_t* Bt; int M, N, K; };
struct StaticOrder {
    int nM, nN, nwg, G, c;
    DI void init(int M, int N, int G_, int c_) { nM = M / BM; nN = N / BM; nwg = nM * nN; G = G_; c = c_; }
    DI bool next(int i, Unit& u) const {
        const long L = (long)i * G + c; if (L >= nwg) return false;
        int wgid = (int)L; { const int q = nwg / NXCD, r = nwg % NXCD, xcd = wgid % NXCD, off = wgid / NXCD; wgid = (xcd < r ? xcd * (q + 1) : r * (q + 1) + (xcd - r) * q) + off; }
        const int nig = WGM * nN, gid = wgid / nig, fm = gid * WGM, gsz = (nM - fm) < WGM ? (nM - fm) : WGM;
        u.pm = fm + ((wgid % nig) % gsz); u.pn = (wgid % nig) / gsz; return true;
    }
};


DI float row_rstd(const float* ss, int row, int fq) {
    const float* p = ss + (size_t)(4 * fq) * T + row;
    float s = (p[0] + p[T]) + (p[2 * T] + p[3 * T]);
    s = xor16_32(s);
    return rsqrtf(s * (1.f / DM) + EPS);
}

struct EpiProj {
    static constexpr bool PERM = true, ROWPERM = false;
    bf16_t* O; const float* ss;
    DI void operator()(f32x4 (&acc)[2][2][4][2], const Unit& u, int wr, int wc, int fr, int fq, LAS unsigned char* lds, int ui) const {
        const int row0 = u.pm * BM + wr * 64 + fr, col0 = u.pn * BM + wc * 32 + 8 * fq;
#pragma unroll
        for (int ai = 0; ai < 2; ++ai)
#pragma unroll
            for (int m = 0; m < 4; ++m) {
                const int row = row0 + ai * HALF + m * 16; const float rs = ((const LAS float*)(lds + RST_OFF))[ui * 256 + ai * HALF + wr * 64 + m * 16 + fr];
                bf16_t* rowp = O + (size_t)row * DIN + col0;
#pragma unroll
                for (int bj = 0; bj < 2; ++bj) { const f32x4 v0 = acc[ai][bj][m][0] * rs, v1 = acc[ai][bj][m][1] * rs;
                    u32x4 w; w.x = pk2(v0[0], v0[1]); w.y = pk2(v0[2], v0[3]); w.z = pk2(v1[0], v1[1]); w.w = pk2(v1[2], v1[3]);
                    *(u32x4*)(rowp + bj * HALF) = w; }
                asm volatile("" ::: "memory");
            }
    }
};

struct EpiRes {
    static constexpr bool PERM = true, ROWPERM = false;
    bf16_t* xb; float* ss;
    DI void operator()(f32x4 (&acc)[2][2][4][2], const Unit& u, int wr, int wc, int fr, int fq, LAS unsigned char* lds, int ui) const {
        const int row0 = u.pm * BM + wr * 64 + fr, col0 = u.pn * BM + wc * 32 + 8 * fq;
#pragma unroll
        for (int ai = 0; ai < 2; ++ai) {
            u32x4 xv[4][2];
#pragma unroll
            for (int m = 0; m < 4; ++m)
#pragma unroll
                for (int bj = 0; bj < 2; ++bj) xv[m][bj] = *(const u32x4*)(xb + (size_t)(row0 + ai * HALF + m * 16) * DM + col0 + bj * HALF);
            float sq[4];
#pragma unroll
            for (int m = 0; m < 4; ++m) {
                bf16_t* rowp = xb + (size_t)(row0 + ai * HALF + m * 16) * DM + col0; float q = 0.f;
#pragma unroll
                for (int bj = 0; bj < 2; ++bj) {
                    const u32x4 x4 = xv[m][bj];
                    const f32x4 a0 = acc[ai][bj][m][0], a1 = acc[ai][bj][m][1];
                    u32x4 w; w.x = pk2(bf_lo(x4.x) + a0[0], bf_hi(x4.x) + a0[1]); w.y = pk2(bf_lo(x4.y) + a0[2], bf_hi(x4.y) + a0[3]);
                    w.z = pk2(bf_lo(x4.z) + a1[0], bf_hi(x4.z) + a1[1]); w.w = pk2(bf_lo(x4.w) + a1[2], bf_hi(x4.w) + a1[3]);
                    *(u32x4*)(rowp + bj * HALF) = w;
                    q += (bf_lo(w.x) * bf_lo(w.x) + bf_hi(w.x) * bf_hi(w.x)) + (bf_lo(w.y) * bf_lo(w.y) + bf_hi(w.y) * bf_hi(w.y))
                       + (bf_lo(w.z) * bf_lo(w.z) + bf_hi(w.z) * bf_hi(w.z)) + (bf_lo(w.w) * bf_lo(w.w) + bf_hi(w.w) * bf_hi(w.w));
                }
                sq[m] = q;
            }
#pragma unroll
            for (int m = 0; m < 4; ++m) { const float q = xor16_32(sq[m]); if (fq == 0) ss[(size_t)(u.pn * 4 + wc) * T + row0 + ai * HALF + m * 16] = q; }
            asm volatile("" ::: "memory");
        }
    }
};

DI float dpp_shr1(float v) { return __int_as_float(__builtin_amdgcn_update_dpp(0, __float_as_int(v), 0x111, 0xf, 0xf, true)); }
DI float silu_mul(float g, float v) { return g * v * __builtin_amdgcn_rcpf(1.f + __builtin_amdgcn_exp2f(-1.44269504089f * g)); }

struct EpiUp {
    static constexpr bool PERM = true, ROWPERM = true;
    bf16_t* act; const float* ss; const float* cw; float* H;
    DI void operator()(f32x4 (&acc)[2][2][4][2], const Unit& u, int wr, int wc, int fr, int fq, LAS unsigned char* lds, int ui) const {
        const int row0 = u.pm * BM + wr * 128 + fr * 8;
        const int ct = wc * 32 + 8 * fq;
        {
            float s8[8];
#pragma unroll
            for (int i = 0; i < 8; ++i) s8[i] = 0.f;
#pragma unroll
            for (int pl = 0; pl < 4; ++pl) { const float* p = ss + (size_t)(4 * fq + pl) * T + row0; const f32x4 a = *(const f32x4*)p, b = *(const f32x4*)(p + 4);
#pragma unroll
                for (int i = 0; i < 4; ++i) { s8[i] += a[i]; s8[4 + i] += b[i]; } }
#pragma unroll
            for (int i = 0; i < 8; ++i) { const float rs = rsqrtf(xor16_32(s8[i]) * (1.f / DM) + EPS);
#pragma unroll
                for (int bj = 0; bj < 2; ++bj)
#pragma unroll
                    for (int n = 0; n < 2; ++n) acc[i >> 2][bj][i & 3][n] *= rs; }
        }
        LAS float* xch = (LAS float*)(lds + XCH_OFF);
        if (fr == 0 && wr == 0) {
#pragma unroll
            for (int k = 0; k < 2; ++k)
#pragma unroll
                for (int bj = 0; bj < 2; ++bj)
#pragma unroll
                    for (int n = 0; n < 2; ++n) *(f32x4*)(H + ((size_t)u.pm * 4 + k) * DUP + u.pn * BM + bj * HALF + ct + 4 * n) = acc[0][bj][k][n];
        }
        if (fr == 15) {
            if (wr == 1) {
#pragma unroll
                for (int k = 0; k < 2; ++k)
#pragma unroll
                    for (int bj = 0; bj < 2; ++bj)
#pragma unroll
                        for (int n = 0; n < 2; ++n) *(f32x4*)(H + ((size_t)u.pm * 4 + 2 + k) * DUP + u.pn * BM + bj * HALF + ct + 4 * n) = acc[1][bj][2 + k][n];
            } else {
#pragma unroll
                for (int k = 0; k < 2; ++k)
#pragma unroll
                    for (int bj = 0; bj < 2; ++bj)
#pragma unroll
                        for (int n = 0; n < 2; ++n) *(LAS f32x4*)(xch + ((wc * 4 + fq) * 2 + k) * 16 + (bj * 2 + n) * 4) = acc[1][bj][2 + k][n];
            }
        }
        asm volatile("s_waitcnt lgkmcnt(0)" ::: "memory");
        __builtin_amdgcn_s_barrier();
        asm volatile("" ::: "memory");
        const size_t cwc = (size_t)u.pn * 128 + ct;
#pragma unroll
        for (int n = 0; n < 2; ++n) {
            f32x4 w[2][3];
#pragma unroll
            for (int bj = 0; bj < 2; ++bj)
#pragma unroll
                for (int k = 0; k < 3; ++k) w[bj][k] = *(const f32x4*)(cw + (size_t)k * DUP + bj * DFF + cwc + 4 * n);
#pragma unroll
            for (int bj = 0; bj < 2; ++bj) {
                f32x4 h1, h2;
#pragma unroll
                for (int e = 0; e < 4; ++e) { h1[e] = dpp_shr1(acc[1][bj][3][n][e]); h2[e] = dpp_shr1(acc[1][bj][2][n][e]); }
                if (fr == 0) {
                    if (wr == 1) { h2 = *(LAS f32x4*)(xch + ((wc * 4 + fq) * 2 + 0) * 16 + (bj * 2 + n) * 4); h1 = *(LAS f32x4*)(xch + ((wc * 4 + fq) * 2 + 1) * 16 + (bj * 2 + n) * 4); }
                    else { h1 = (f32x4){0.f, 0.f, 0.f, 0.f}; h2 = h1; }
                }
#pragma unroll
                for (int i = 7; i >= 0; --i) {
                    const f32x4 p0 = acc[i >> 2][bj][i & 3][n];
                    const f32x4 p1 = (i >= 1) ? acc[(i - 1) >> 2][bj][(i - 1) & 3][n] : h1;
                    const f32x4 p2 = (i >= 2) ? acc[(i - 2) >> 2][bj][(i - 2) & 3][n] : (i == 1 ? h1 : h2);
                    acc[i >> 2][bj][i & 3][n] = w[bj][2] * p0 + w[bj][1] * p1 + w[bj][0] * p2;
                }
            }
#pragma unroll
            for (int i = 0; i < 8; ++i)
#pragma unroll
                for (int e = 0; e < 4; ++e) acc[i >> 2][0][i & 3][n][e] = silu_mul(acc[i >> 2][0][i & 3][n][e], acc[i >> 2][1][i & 3][n][e]);
            asm volatile("" ::: "memory");
        }
#pragma unroll
        for (int i = 0; i < 8; ++i) { const f32x4 v0 = acc[i >> 2][0][i & 3][0], v1 = acc[i >> 2][0][i & 3][1];
            u32x4 o; o.x = pk2(v0[0], v0[1]); o.y = pk2(v0[2], v0[3]); o.z = pk2(v1[0], v1[1]); o.w = pk2(v1[2], v1[3]);
            *(u32x4*)(act + (size_t)(row0 + i) * DFF + cwc) = o; asm volatile("" ::: "memory"); }
    }
};

DI void rstd_table(LAS unsigned char* lds, const StaticOrder& S, const float* __restrict__ ss, const int tid) {
    LAS float* rt = (LAS float*)(lds + RST_OFF);
    const int row = tid & 255, par = tid >> 8;
    Unit u;
    for (int i = par; S.next(i, u); i += 2) {
        const float* p = ss + (size_t)u.pm * BM + row; float s = 0.f;
#pragma unroll
        for (int pl = 0; pl < 16; ++pl) s += p[(size_t)pl * T];
        rt[i * 256 + row] = rsqrtf(s * (1.f / DM) + EPS);
    }
    __syncthreads();
}

template <class Epi>
DI void gemm_phase(LAS unsigned char* lds, const Gemm g, const StaticOrder& S, const Epi& E, const int tid) {
    const int wid = __builtin_amdgcn_readfirstlane(tid >> 6), lane = tid & 63, wr = wid >> 2, wc = wid & 3, fr = lane & 15, fq = lane >> 4;
    const int K = g.K, nt = K / BK;
    unsigned voffA[2], voffB[2];
#pragma unroll
    for (int i = 0; i < 2; ++i) { int R, C; stage_rc(tid * 16 + i * 8192, R, C); const int Rb = Epi::PERM ? ((R & ~31) + perm32(R & 31)) : R;
        voffB[i] = (unsigned)(Rb * K + C) * 2u;
        const int Ra = Epi::ROWPERM ? (128 * (R >> 6) + 8 * (R & 15) + ((R >> 4) & 3)) : R;
        voffA[i] = (unsigned)(Ra * K + C) * 2u; }
    const size_t kstep = (size_t)(BK * 2);
    const size_t hstep = (size_t)HALF * K * 2;
    const size_t tstep = 2 * hstep;
    const size_t astep = Epi::ROWPERM ? (size_t)4 * K * 2 : hstep;
    const unsigned ldsw = (unsigned)wid * 1024u;
    const int aoff = lds_byte(wr * 64 + fr, fq * 8), boff = lds_byte(wc * 32 + fr, fq * 8);
#define PG8_SA(b, h) (((b) * 2 + (h)) * HTB)
#define PG8_SB(b, h) ((4 + (b) * 2 + (h)) * HTB)
#define PG8_STAGE(bufoff, gbase, voff) do { _Pragma("unroll") for (int _i = 0; _i < 2; ++_i) \
        __builtin_amdgcn_global_load_lds((const unsigned*)((const char*)(gbase) + (voff)[_i]), (LAS unsigned*)(lds + (bufoff) + ldsw + _i * 8192), 16, 0, 0); } while (0)
#define PG8_LDA(dst, b, h) do { _Pragma("unroll") for (int m = 0; m < 4; ++m) _Pragma("unroll") for (int k = 0; k < 2; ++k) dst[m][k] = *(const LAS bf16x8*)(lds + PG8_SA(b, h) + aoff + m * 2048 + k * 1024); } while (0)
#define PG8_LDB(dst, b, h) do { _Pragma("unroll") for (int n = 0; n < 2; ++n) _Pragma("unroll") for (int k = 0; k < 2; ++k) dst[n][k] = *(const LAS bf16x8*)(lds + PG8_SB(b, h) + boff + n * 2048 + k * 1024); } while (0)
#define PG8_MMA(ai, bj, At, Bt) do { __builtin_amdgcn_s_setprio(1); _Pragma("unroll") for (int m = 0; m < 4; ++m) _Pragma("unroll") for (int n = 0; n < 2; ++n) _Pragma("unroll") for (int k = 0; k < 2; ++k) \
        acc[ai][bj][m][n] = __builtin_amdgcn_mfma_f32_16x16x32_bf16(Bt[n][k], At[m][k], acc[ai][bj][m][n], 0, 0, 0); __builtin_amdgcn_s_setprio(0); } while (0)
#define PG8_WAIT_V(n) asm volatile("s_waitcnt vmcnt(" #n ")" ::: "memory")
#define PG8_WAIT_L(n) asm volatile("s_waitcnt lgkmcnt(" #n ")" ::: "memory")
#define PG8_BAR __builtin_amdgcn_s_barrier()
#define PG8_SCHED __builtin_amdgcn_sched_barrier(0)
    Unit cur, nxt; int ui = 0;
    if (!S.next(0, cur)) return;
    f32x4 acc[2][2][4][2];
#pragma unroll
    for (int a = 0; a < 2; ++a)
#pragma unroll
        for (int b = 0; b < 2; ++b)
#pragma unroll
            for (int m = 0; m < 4; ++m)
#pragma unroll
                for (int n = 0; n < 2; ++n) acc[a][b][m][n] = (f32x4){0.f, 0.f, 0.f, 0.f};
    bf16x8 At[4][2], B0[2][2], B1[2][2];
    const char* cA = (const char*)g.A + (size_t)cur.pm * tstep; const char* cB = (const char*)g.Bt + (size_t)cur.pn * tstep;
    PG8_STAGE(PG8_SB(0, 0), cB, voffB); PG8_STAGE(PG8_SB(0, 1), cB + hstep, voffB); PG8_STAGE(PG8_SA(0, 0), cA, voffA); PG8_STAGE(PG8_SA(0, 1), cA + astep, voffA);
    if (wr == 1) PG8_BAR;
    PG8_WAIT_V(2); PG8_BAR;
    PG8_STAGE(PG8_SB(1, 0), cB + kstep, voffB); PG8_STAGE(PG8_SA(1, 0), cA + kstep, voffA); PG8_STAGE(PG8_SB(1, 1), cB + hstep + kstep, voffB);
    PG8_WAIT_V(6); PG8_BAR;
    for (;;) {
        const bool has_next = S.next(ui + 1, nxt);
        const char* nA = has_next ? (const char*)g.A + (size_t)nxt.pm * tstep : cA; const char* nB = has_next ? (const char*)g.Bt + (size_t)nxt.pn * tstep : cB;
        for (int t = 0; t < nt; t += 2) {
            const bool last = (t == nt - 2);
            const char* a1 = cA + (size_t)(t + 1) * kstep;
            const char* a2 = last ? nA : cA + (size_t)(t + 2) * kstep; const char* b2 = last ? nB : cB + (size_t)(t + 2) * kstep;
            const char* a3 = a2 + kstep; const char* b3 = b2 + kstep;
            PG8_LDB(B0, 0, 0); PG8_LDB(B1, 0, 1); PG8_SCHED; PG8_LDA(At, 0, 0); PG8_STAGE(PG8_SA(1, 1), a1 + astep, voffA);
            PG8_WAIT_V(8); PG8_WAIT_L(0); PG8_BAR; PG8_MMA(0, 0, At, B0); PG8_MMA(0, 1, At, B1); PG8_BAR; PG8_SCHED;
            PG8_LDA(At, 0, 1); PG8_STAGE(PG8_SB(0, 0), b2, voffB); PG8_STAGE(PG8_SB(0, 1), b2 + hstep, voffB); PG8_STAGE(PG8_SA(0, 0), a2, voffA);
            PG8_WAIT_V(8); PG8_WAIT_L(0); PG8_BAR; PG8_MMA(1, 0, At, B0); PG8_MMA(1, 1, At, B1); PG8_BAR; PG8_SCHED;
            PG8_LDB(B0, 1, 0); PG8_LDB(B1, 1, 1); PG8_SCHED; PG8_LDA(At, 1, 0); PG8_STAGE(PG8_SA(0, 1), a2 + astep, voffA);
            PG8_WAIT_V(8); PG8_WAIT_L(0); PG8_BAR; PG8_MMA(0, 0, At, B0); PG8_MMA(0, 1, At, B1); PG8_BAR; PG8_SCHED;
            PG8_LDA(At, 1, 1); PG8_STAGE(PG8_SB(1, 0), b3, voffB); PG8_STAGE(PG8_SB(1, 1), b3 + hstep, voffB); PG8_STAGE(PG8_SA(1, 0), a3, voffA);
            PG8_WAIT_V(8); PG8_WAIT_L(0); PG8_BAR; PG8_MMA(1, 0, At, B0); PG8_MMA(1, 1, At, B1); PG8_BAR; PG8_SCHED;
        }
        { int fr2 = fr, fq2 = fq; asm volatile("" : "+v"(fr2), "+v"(fq2));
          E(acc, cur, wr, wc, fr2, fq2, lds, ui); }
        if (!has_next) break;
#pragma unroll
        for (int a = 0; a < 2; ++a)
#pragma unroll
            for (int b = 0; b < 2; ++b)
#pragma unroll
                for (int m = 0; m < 4; ++m)
#pragma unroll
                    for (int n = 0; n < 2; ++n) acc[a][b][m][n] = (f32x4){0.f, 0.f, 0.f, 0.f};
        cur = nxt; cA = nA; cB = nB; ++ui;
    }
    PG8_WAIT_V(0);
    if (wr == 0) PG8_BAR;
    PG8_BAR;
#undef PG8_SA
#undef PG8_SB
#undef PG8_STAGE
#undef PG8_LDA
#undef PG8_LDB
#undef PG8_MMA
#undef PG8_WAIT_V
#undef PG8_WAIT_L
#undef PG8_BAR
#undef PG8_SCHED
}

struct WItem { const float* W; const float* g; bf16_t* WT; int K, N, k0, n0, drow0; };
DI void transpose_load(const WItem& w, float (&v)[32], int lane) {
    const float* rb = w.W + (size_t)w.k0 * w.N + w.n0;
    const unsigned lo = (unsigned)(lane >> 5) * (unsigned)w.N + (unsigned)(lane & 31), hl = (unsigned)(lane >> 5);
    const float* gb = w.g ? w.g + w.k0 : nullptr;
#pragma unroll
    for (int i = 0; i < 32; ++i) { const float gv = gb ? gb[hl + 2u * i] : 1.f;
        v[i] = rb[lo + (unsigned)(2 * i) * (unsigned)w.N] * gv; }
}
DI void transpose_finish(const WItem& w, const float (&v)[32], LAS float* scr, int lane) {
#pragma unroll
    for (int i = 0; i < 32; ++i) scr[(2 * i + (lane >> 5)) * 33 + (lane & 31)] = v[i];
    asm volatile("s_waitcnt lgkmcnt(0)" ::: "memory");
    const int c = lane & 7;
#pragma unroll
    for (int j = 0; j < 4; ++j) { const int n = (lane >> 3) + 8 * j; const LAS float* sp = scr + (8 * c) * 33 + n;
        u32x4 o; o.x = pk2(sp[0], sp[33]); o.y = pk2(sp[2 * 33], sp[3 * 33]); o.z = pk2(sp[4 * 33], sp[5 * 33]); o.w = pk2(sp[6 * 33], sp[7 * 33]);
        *(u32x4*)(w.WT + (size_t)(w.drow0 + n) * w.K + w.k0 + 8 * c) = o; }
    asm volatile("s_waitcnt lgkmcnt(0)" ::: "memory");
}

constexpr int I_IN = 16 * 96, I_OUT = 16 * 32, I_UP = 16 * 176, I_DN = 44 * 32, I_L = I_IN + I_OUT + I_UP + I_DN;
DI WItem weight_desc(PP p, int it) {
    WItem w; const int l = it / I_L; int r = it % I_L;
    if (r < I_IN) { const int kb = r / 96, nb = r % 96;
        w.W = p->w_in + (size_t)l * DM * DIN; w.g = p->norm1_g + l * DM; w.K = DM; w.N = DIN; w.WT = (bf16_t*)(p->ws + WS_WIN + l * SZ_WIN); w.k0 = kb * 64; w.n0 = nb * 32; w.drow0 = nb * 32; return w; }
    r -= I_IN;
    if (r < I_OUT) { const int kb = r / 32, nb = r % 32;
        w.W = p->w_out + (size_t)l * DM * DM; w.g = nullptr; w.K = DM; w.N = DM; w.WT = (bf16_t*)(p->ws + WS_WOUT + l * SZ_WOUT); w.k0 = kb * 64; w.n0 = nb * 32; w.drow0 = nb * 32; return w; }
    r -= I_OUT;
    if (r < I_UP) { const int kb = r / 176, nb = r % 176; const int n0 = nb * 32;
        const int drow = (n0 < DFF) ? ((n0 / 128) * 256 + (n0 % 128)) : (((n0 - DFF) / 128) * 256 + 128 + ((n0 - DFF) % 128));
        w.W = p->ffn_up + (size_t)l * DM * DUP; w.g = p->norm2_g + l * DM; w.K = DM; w.N = DUP; w.WT = (bf16_t*)(p->ws + WS_WUP + l * SZ_WUP); w.k0 = kb * 64; w.n0 = n0; w.drow0 = drow; return w; }
    r -= I_UP;
    { const int kb = r / 32, nb = r % 32;
        w.W = p->ffn_down + (size_t)l * DFF * DM; w.g = nullptr; w.K = DFF; w.N = DM; w.WT = (bf16_t*)(p->ws + WS_WDN + l * SZ_WDN); w.k0 = kb * 64; w.n0 = nb * 32; w.drow0 = nb * 32; return w; }
}
DI void weight_item(PP p, int it, LAS float* scr, int lane) { const WItem w = weight_desc(p, it); float v[32]; transpose_load(w, v, lane); transpose_finish(w, v, scr, lane); }
DI void weight_item2(PP p, int it0, int it1, bool has1, LAS float* scr, int lane) {
    const WItem w0 = weight_desc(p, it0), w1 = weight_desc(p, has1 ? it1 : it0);
    float v0[32], v1[32];
    transpose_load(w0, v0, lane); transpose_load(w1, v1, lane);
    transpose_finish(w0, v0, scr, lane);
    if (has1) transpose_finish(w1, v1, scr, lane);
}

DI void phase_prep(PP p, LAS unsigned char* lds, const int tid) {
    const int lane = tid & 63, wave = __builtin_amdgcn_readfirstlane(tid >> 6);
    const int gw = blockIdx.x * 8 + wave, NGW = gridDim.x * 8;
    {
        bf16_t* xb = (bf16_t*)(p->ws + WS_XB); float* ss = (float*)(p->ws + WS_SS); const float* x = p->x;
        for (int row0 = gw * 4; row0 < T; row0 += NGW * 4) {
            f32x4 xa[4][2], xc[4][2];
#pragma unroll
            for (int q = 0; q < 4; ++q)
#pragma unroll
                for (int j = 0; j < 2; ++j) { const size_t o = (size_t)(row0 + q) * DM + 8 * lane + 512 * j; xa[q][j] = *(const f32x4*)(x + o); xc[q][j] = *(const f32x4*)(x + o + 4); }
#pragma unroll
            for (int q = 0; q < 4; ++q) {
                float sq = 0.f;
#pragma unroll
                for (int j = 0; j < 2; ++j) { const size_t o = (size_t)(row0 + q) * DM + 8 * lane + 512 * j; const f32x4 a = xa[q][j], b = xc[q][j];
                    u32x4 w; w.x = pk2(a[0], a[1]); w.y = pk2(a[2], a[3]); w.z = pk2(b[0], b[1]); w.w = pk2(b[2], b[3]);
                    *(u32x4*)(xb + o) = w;
                    sq += (bf_lo(w.x) * bf_lo(w.x) + bf_hi(w.x) * bf_hi(w.x)) + (bf_lo(w.y) * bf_lo(w.y) + bf_hi(w.y) * bf_hi(w.y))
                        + (bf_lo(w.z) * bf_lo(w.z) + bf_hi(w.z) * bf_hi(w.z)) + (bf_lo(w.w) * bf_lo(w.w) + bf_hi(w.w) * bf_hi(w.w)); }
#pragma unroll
                for (int o = 1; o < 64; o <<= 1) sq += __shfl_xor(sq, o);
                if (lane < 16) ss[(size_t)lane * T + row0 + q] = (lane == 0) ? sq : 0.f;
            }
        }
    }
    LAS float* scr = (LAS float*)(lds + wave * 8448);
    for (int it = gw; it < I_IN; it += NGW) weight_item(p, it, scr, lane);
}

struct KV { u32x4 k[4]; u32x4 v[4]; };
constexpr int NT = 23;
DI bool tile_desc(int tt, int p0, int& kbase, int& kstride, int& W, int& cls) {
    if (tt < 8) { kstride = 1; kbase = p0 - 128 + 32 * tt; W = 128; cls = -1; }
    else if (tt < 11) { kstride = 4; kbase = p0 - 512 + 128 * (tt - 8); W = 512; cls = 0; }
    else { kstride = 4; kbase = p0 - 640 - 128 * (tt - 11); W = 2048; cls = 1; }
    return kbase + kstride * 31 >= 0;
}
DI int next_tile(int tt, int p0) { int kb, ks, W, cls; for (++tt; tt < NT; ++tt) if (tile_desc(tt, p0, kb, ks, W, cls)) break; return tt; }
DI void load_kv_at(KV& t, const bf16_t* __restrict__ base, int h, int kbase, int kstride, int vrow0, int vch) {
#pragma unroll
    for (int i = 0; i < 4; ++i) { int vpos = kbase + kstride * (vrow0 + 8 * i); vpos = vpos < 0 ? 0 : vpos;
        const bf16_t* rp = base + (size_t)vpos * DIN + h * 64 + 8 * vch;
        t.k[i] = *(const u32x4*)(rp + 512); t.v[i] = *(const u32x4*)(rp + 1024); }
}
DI void load_kv(KV& t, const bf16_t* __restrict__ base, int h, int tt, int p0, const bf16_t* __restrict__ nbase, int nh, int np0, int vrow0, int vch) {
    const bool here = tt < NT;
    int kbase, kstride, W, cls; tile_desc(here ? tt : next_tile(-1, np0), here ? p0 : np0, kbase, kstride, W, cls);
    load_kv_at(t, here ? base : nbase, here ? h : nh, kbase, kstride, vrow0, vch);
}

struct AttnState { float mrun, lrun; f32x16 o0, o1; };

DI void attn_tile(AttnState& st, const KV& t, const bf16x8 (&qf)[4], int tt, int p0, int qpos, int r, int hh, int vrow0, int vch, LAS unsigned char* vptr, unsigned ta0, unsigned ta1, float slope2, float sc) {
    int kbase, kstride, W, cls; tile_desc(tt, p0, kbase, kstride, W, cls);
#pragma unroll
    for (int i = 0; i < 4; ++i) { const int vr = vrow0 + 8 * i;
        *(LAS u32x4*)(vptr + 4096 + vr * 128 + ((vch ^ (vr & 7)) << 4)) = t.k[i];
        *(LAS u32x4*)(vptr + vr * 128 + ((vch * 16) ^ (((vr >> 1) & 1) << 6))) = t.v[i]; }
    bf16x8 kf[4];
#pragma unroll
    for (int c = 0; c < 4; ++c) kf[c] = *(const LAS bf16x8*)(vptr + 4096 + r * 128 + (((2 * c + hh) ^ (r & 7)) << 4));
    f32x16 S;
#pragma unroll
    for (int i = 0; i < 16; ++i) S[i] = 0.f;
#pragma unroll
    for (int c = 0; c < 4; ++c) S = __builtin_amdgcn_mfma_f32_32x32x16_bf16(kf[c], qf[c], S, 0, 0, 0);
#define SC_(x) asm("" : "+v"(x))
    const float dist0 = (float)(qpos - kbase - kstride * 4 * hh), nks = -(float)kstride, nsl = -slope2;
    float sv[16];
    float tmax = -3.0e38f;
    if (cls < 0) {
        const float half = 0.5f * (float)(qpos < W ? qpos : W), dpb = dist0 - half, K0 = -slope2 * half;
        const float hq = 0.5f * (float)qpos;
        const int e3 = (r - hh) & 3; const bool pe0 = e3 == 0, pe2 = e3 == 2;
#pragma unroll
        for (int i = 0; i < 16; ++i) { const float cf = (float)((i & 3) + 8 * (i >> 2));
            float dp = __builtin_fmaf(nks, cf, dpb);
            SC_(dp);
            float sx = __builtin_fmaf(S[i], sc, __builtin_fmaf(dp, nsl, K0));
            const bool v1 = __builtin_fabsf(dp) <= half;
            if ((i & 3) == 0) {
                const bool v4 = __builtin_fabsf(dp + (half - hq)) <= hq;
                const bool v16 = (((i >> 2) & 1) ? pe2 : pe0) && v4;
                const float add = v1 ? (v16 ? 1.5849625f : 1.f) : (v16 ? 1.f : 0.f);
                sx = v4 ? sx + add : -3.0e38f;
            } else sx = v1 ? sx : -3.0e38f;
            SC_(sx);
            sv[i] = sx; tmax = fmaxf(tmax, sx); }
    } else {
        const float hA = (cls == 0) ? 0.5f * (float)(qpos < 512 ? qpos : 512) : -1.f;
        const float hB = 0.5f * (float)qpos;
        const int rc = r & 3;
#pragma unroll
        for (int i = 0; i < 16; ++i) { const float cf = (float)((i & 3) + 8 * (i >> 2));
            float dist = __builtin_fmaf(nks, cf, dist0);
            SC_(dist);
            const bool vA = __builtin_fabsf(dist - hA) <= hA;
            const bool vB = (rc == (i & 3)) && (__builtin_fabsf(dist - hB) <= hB);
            float sx = __builtin_fmaf(S[i], sc, dist * nsl);
            sx += (vA && vB) ? 1.f : 0.f;
            sx = (vA || vB) ? sx : -3.0e38f;
            SC_(sx);
            sv[i] = sx; tmax = fmaxf(tmax, sx); }
    }
    s16x4 t0, t1, t2, t3, t4, t5, t6, t7;
    asm volatile("s_waitcnt lgkmcnt(0)\n\t"
                 "ds_read_b64_tr_b16 %0, %8\n\tds_read_b64_tr_b16 %1, %8 offset:1024\n\tds_read_b64_tr_b16 %2, %8 offset:2048\n\tds_read_b64_tr_b16 %3, %8 offset:3072\n\t"
                 "ds_read_b64_tr_b16 %4, %9\n\tds_read_b64_tr_b16 %5, %9 offset:1024\n\tds_read_b64_tr_b16 %6, %9 offset:2048\n\tds_read_b64_tr_b16 %7, %9 offset:3072"
                 : "=&v"(t0), "=&v"(t1), "=&v"(t2), "=&v"(t3), "=&v"(t4), "=&v"(t5), "=&v"(t6), "=&v"(t7) : "v"(ta0), "v"(ta1) : "memory");
    if (__builtin_amdgcn_ballot_w64(tmax > st.mrun + 8.f) != 0ull) {
        tmax = fmaxf(tmax, __shfl_xor(tmax, 32));
        const float mnew = fmaxf(st.mrun, tmax), alpha = __builtin_amdgcn_exp2f(st.mrun - mnew); st.mrun = mnew;
        st.lrun *= alpha;
#pragma unroll
        for (int i = 0; i < 16; ++i) { float a0 = st.o0[i] * alpha, a1 = st.o1[i] * alpha; SC_(a0); SC_(a1); st.o0[i] = a0; st.o1[i] = a1; }
    }
    const float mn = st.mrun;
    float psum = 0.f;
#pragma unroll
    for (int i = 0; i < 16; ++i) { float e = sv[i] - mn; SC_(e); float pv = __builtin_amdgcn_exp2f(e); SC_(pv); S[i] = pv; psum += pv; }
    st.lrun += psum;
#undef SC_
    bf16x8 pf[2];
#pragma unroll
    for (int s = 0; s < 2; ++s) { u32x4 w; w.x = pk2(S[8 * s], S[8 * s + 1]); w.y = pk2(S[8 * s + 2], S[8 * s + 3]); w.z = pk2(S[8 * s + 4], S[8 * s + 5]); w.w = pk2(S[8 * s + 6], S[8 * s + 7]);
        pf[s] = __builtin_bit_cast(bf16x8, w); }
    asm volatile("s_waitcnt lgkmcnt(0)" : "+v"(t0), "+v"(t1), "+v"(t2), "+v"(t3), "+v"(t4), "+v"(t5), "+v"(t6), "+v"(t7) :: "memory");
    const bf16x8 v00 = __builtin_shufflevector(t0, t1, 0, 1, 2, 3, 4, 5, 6, 7), v01 = __builtin_shufflevector(t2, t3, 0, 1, 2, 3, 4, 5, 6, 7);
    const bf16x8 v10 = __builtin_shufflevector(t4, t5, 0, 1, 2, 3, 4, 5, 6, 7), v11 = __builtin_shufflevector(t6, t7, 0, 1, 2, 3, 4, 5, 6, 7);
    st.o0 = __builtin_amdgcn_mfma_f32_32x32x16_bf16(v00, pf[0], st.o0, 0, 0, 0);
    st.o0 = __builtin_amdgcn_mfma_f32_32x32x16_bf16(v01, pf[1], st.o0, 0, 0, 0);
    st.o1 = __builtin_amdgcn_mfma_f32_32x32x16_bf16(v10, pf[0], st.o1, 0, 0, 0);
    st.o1 = __builtin_amdgcn_mfma_f32_32x32x16_bf16(v11, pf[1], st.o1, 0, 0, 0);
}

DI void attn_item(const bf16_t* __restrict__ proj, bf16_t* __restrict__ mixed, const float* __restrict__ og, unsigned vlds, LAS unsigned char* vptr, int b, int h, int p0,
                  int nb, int nh, int np0, KV& ta, bf16x8 (&qf)[4], int lane) {
    const int r = lane & 31, hh = lane >> 5;
    const bf16_t* base = proj + (size_t)b * SEQ * DIN; const bf16_t* nbase = proj + (size_t)nb * SEQ * DIN;
    const int qpos = p0 + 4 * r;
    AttnState st; st.mrun = -1e30f; st.lrun = 0.f;
#pragma unroll
    for (int i = 0; i < 16; ++i) { st.o0[i] = 0.f; st.o1[i] = 0.f; }
    const float slope2 = __builtin_amdgcn_exp2f(-(float)(h + 1)) * 1.44269504089f;
    const float sc = 0.125f * 1.44269504089f;
    const int i16 = lane & 15, tq = i16 >> 2, tp = i16 & 3, gsub = (lane >> 4) & 1;
    const unsigned ta0 = vlds + (unsigned)((4 * hh + tq) * 128 + ((32 * gsub + 8 * tp) ^ (64 * ((tq >> 1) & 1))));
    const unsigned ta1 = ta0 ^ 64u;
    const int vrow0 = lane >> 3, vch = lane & 7;
    KV tb;
    int cur = next_tile(-1, p0);
    bool in_tb;
    for (;;) {
        int nxt = next_tile(cur, p0);
        load_kv(tb, base, h, nxt, p0, nbase, nh, np0, vrow0, vch);
        attn_tile(st, ta, qf, cur, p0, qpos, r, hh, vrow0, vch, vptr, ta0, ta1, slope2, sc);
        if (nxt >= NT) { in_tb = true; break; }
        cur = nxt; nxt = next_tile(cur, p0);
        load_kv(ta, base, h, nxt, p0, nbase, nh, np0, vrow0, vch);
        attn_tile(st, tb, qf, cur, p0, qpos, r, hh, vrow0, vch, vptr, ta0, ta1, slope2, sc);
        if (nxt >= NT) { in_tb = false; break; }
        cur = nxt;
    }
    { const int nq = np0 + 4 * r;
#pragma unroll
      for (int c = 0; c < 4; ++c) qf[c] = *(const bf16x8*)(nbase + (size_t)nq * DIN + nh * 64 + 16 * c + 8 * hh); }
    float lrun = st.lrun + __shfl_xor(st.lrun, 32);
    const float inv = 1.f / lrun;
    float ssq = 0.f;
#pragma unroll
    for (int i = 0; i < 16; ++i) { st.o0[i] *= inv; st.o1[i] *= inv; ssq += st.o0[i] * st.o0[i] + st.o1[i] * st.o1[i]; }
    ssq += __shfl_xor(ssq, 32);
    const float rstd = rsqrtf(ssq * (1.f / 64.f) + EPS);
    bf16_t* orow = mixed + ((size_t)b * SEQ + qpos) * DM + h * 64;
#pragma unroll
    for (int gi = 0; gi < 4; ++gi) { const int d0 = 8 * gi + 4 * hh;
        const f32x4 g0 = *(const f32x4*)(og + h * 64 + d0), g1 = *(const f32x4*)(og + h * 64 + 32 + d0);
        u32x2 w0, w1;
        w0.x = pk2(st.o0[4 * gi] * rstd * g0[0], st.o0[4 * gi + 1] * rstd * g0[1]); w0.y = pk2(st.o0[4 * gi + 2] * rstd * g0[2], st.o0[4 * gi + 3] * rstd * g0[3]);
        w1.x = pk2(st.o1[4 * gi] * rstd * g1[0], st.o1[4 * gi + 1] * rstd * g1[1]); w1.y = pk2(st.o1[4 * gi + 2] * rstd * g1[2], st.o1[4 * gi + 3] * rstd * g1[3]);
        *(u32x2*)(orow + d0) = w0; *(u32x2*)(orow + 32 + d0) = w1; }
    if (in_tb) ta = tb;
}

DI void unpack8(const u32x4 v, float (&f)[8]) { f[0] = bf_lo(v.x); f[1] = bf_hi(v.x); f[2] = bf_lo(v.y); f[3] = bf_hi(v.y); f[4] = bf_lo(v.z); f[5] = bf_hi(v.z); f[6] = bf_lo(v.w); f[7] = bf_hi(v.w); }

DI void phase_mixer(PP p, int layer, LAS unsigned char* lds, const int tid) {
    const int lane = tid & 63, wave = __builtin_amdgcn_readfirstlane(tid >> 6);
    const bf16_t* proj = (const bf16_t*)(p->ws + WS_PROJ); bf16_t* mixed = (bf16_t*)(p->ws + WS_MIX);
    const int G = gridDim.x, bid = blockIdx.x;
    const int vB = (G % 8 == 0) ? ((bid % 8) * (G / 8) + bid / 8) : bid;
    {
        const float* cw = p->mix_conv_w + (size_t)layer * 3 * 512; const float* cg_ = p->conv_out_g + (size_t)layer * 512;
        const int ch0 = 8 * lane; const int NW = G * 8, gw = vB * 8 + wave; const int per = T / NW;
        float w0[8], w1[8], w2[8], gg[8];
#pragma unroll
        for (int i = 0; i < 8; ++i) { w0[i] = cw[ch0 + i]; w1[i] = cw[512 + ch0 + i]; w2[i] = cw[1024 + ch0 + i]; gg[i] = cg_[ch0 + i]; }
        const int t0 = gw * per;
        float p1[8], p2[8];
#pragma unroll
        for (int i = 0; i < 8; ++i) { p1[i] = 0.f; p2[i] = 0.f; }
        if ((t0 % SEQ) != 0) {
            float a[8], c[8];
            unpack8(*(const u32x4*)(proj + (size_t)(t0 - 2) * DIN + 2048 + ch0), a); unpack8(*(const u32x4*)(proj + (size_t)(t0 - 2) * DIN + 2560 + ch0), c);
#pragma unroll
            for (int i = 0; i < 8; ++i) p2[i] = a[i] * c[i];
            unpack8(*(const u32x4*)(proj + (size_t)(t0 - 1) * DIN + 2048 + ch0), a); unpack8(*(const u32x4*)(proj + (size_t)(t0 - 1) * DIN + 2560 + ch0), c);
#pragma unroll
            for (int i = 0; i < 8; ++i) p1[i] = a[i] * c[i];
        }
        for (int t = t0; t < t0 + per; t += 4) {
            u32x4 rb[4], ra[4], rc[4];
#pragma unroll
            for (int q = 0; q < 4; ++q) { const bf16_t* pr = proj + (size_t)(t + q) * DIN + ch0; rb[q] = *(const u32x4*)(pr + 1536); ra[q] = *(const u32x4*)(pr + 2048); rc[q] = *(const u32x4*)(pr + 2560); }
#pragma unroll
            for (int q = 0; q < 4; ++q) {
                float gb[8], a[8], c[8], y[8];
                unpack8(rb[q], gb); unpack8(ra[q], a); unpack8(rc[q], c);
                float sq = 0.f;
#pragma unroll
                for (int i = 0; i < 8; ++i) { const float cu = a[i] * c[i]; y[i] = gb[i] * (w0[i] * p2[i] + w1[i] * p1[i] + w2[i] * cu); p2[i] = p1[i]; p1[i] = cu; sq += y[i] * y[i]; }
                sq += __shfl_xor(sq, 1); sq += __shfl_xor(sq, 2); sq += __shfl_xor(sq, 4);
                const float rs = rsqrtf(sq * (1.f / 64.f) + EPS);
                u32x4 o; o.x = pk2(y[0] * rs * gg[0], y[1] * rs * gg[1]); o.y = pk2(y[2] * rs * gg[2], y[3] * rs * gg[3]); o.z = pk2(y[4] * rs * gg[4], y[5] * rs * gg[5]); o.w = pk2(y[6] * rs * gg[6], y[7] * rs * gg[7]);
                *(u32x4*)(mixed + (size_t)(t + q) * DM + 512 + ch0) = o;
            }
        }
    }
    {
        const float* og = p->attn_out_g + (size_t)layer * 512;
        LAS unsigned char* vptr = lds + wave * 8192; const unsigned vlds = (unsigned)(size_t)vptr;
        if (G == 256) {
            const int xcd = vB / 32, wl = (vB % 32) * 8 + wave;
            LAS float* scr = (LAS float*)(lds + 65536 + wave * 8448); const int gw = bid * 8 + wave; int wit = I_IN + gw;
            KV ta; bf16x8 qf[4];
            { const int bh = xcd * 16 + wl / 64, c = wl % 64, p0 = 128 * (c >> 2) + (c & 3);
              const bf16_t* base = proj + (size_t)(bh >> 3) * SEQ * DIN; const int r = lane & 31, hh = lane >> 5;
#pragma unroll
              for (int cc = 0; cc < 4; ++cc) qf[cc] = *(const bf16x8*)(base + (size_t)(p0 + 4 * r) * DIN + (bh & 7) * 64 + 16 * cc + 8 * hh);
              int kb, ks, W, cls; tile_desc(next_tile(-1, p0), p0, kb, ks, W, cls); load_kv_at(ta, base, bh & 7, kb, ks, lane >> 3, lane & 7); }
            for (int k = 0; k < 4; ++k) {
                const int bh = xcd * 16 + k * 4 + wl / 64, c = (wl % 64 + 16 * k) % 64;
                const int kn = k < 3 ? k + 1 : k, nbh = xcd * 16 + kn * 4 + wl / 64, nc = (wl % 64 + 16 * kn) % 64;
                attn_item(proj, mixed, og, vlds, vptr, bh >> 3, bh & 7, 128 * (c >> 2) + (c & 3), nbh >> 3, nbh & 7, 128 * (nc >> 2) + (nc & 3), ta, qf, lane);
                if (layer == 0 && wit < NL * I_L) { weight_item2(p, wit, wit + G * 8, wit + G * 8 < NL * I_L, scr, lane); wit += 2 * G * 8; }
            }
        }
    }
}

DI void fixup_tile(PP p, int layer, const int tid, const int pm) {
    if ((pm & 7) == 0) return;
    const float* H = (const float*)(p->ws + WS_H); bf16_t* act = (bf16_t*)(p->ws + WS_PROJ); const float* cw = p->ffn_conv_w + (size_t)layer * 3 * DUP;
    const float* Hc = H + (size_t)pm * 4 * DUP; const float* Hp = H + (size_t)(pm - 1) * 4 * DUP;
    for (int idx = tid; idx < 2 * DFF; idx += 512) {
        const int i = idx / DFF, c = idx % DFF;
        const int gcol = (c >> 7) * 256 + (c & 127), vcol = gcol + 128;
        float g0, g1, g2, v0, v1, v2;
        if (i == 0) { g0 = Hc[gcol]; g1 = Hp[3 * DUP + gcol]; g2 = Hp[2 * DUP + gcol]; v0 = Hc[vcol]; v1 = Hp[3 * DUP + vcol]; v2 = Hp[2 * DUP + vcol]; }
        else { g0 = Hc[DUP + gcol]; g1 = Hc[gcol]; g2 = Hp[3 * DUP + gcol]; v0 = Hc[DUP + vcol]; v1 = Hc[vcol]; v2 = Hp[3 * DUP + vcol]; }
        const float yg = cw[2 * DUP + c] * g0 + cw[DUP + c] * g1 + cw[c] * g2;
        const float yv = cw[2 * DUP + DFF + c] * v0 + cw[DUP + DFF + c] * v1 + cw[DFF + c] * v2;
        const float a = silu_mul(yg, yv);
        const unsigned pk = pk2(a, a);
        act[(size_t)(pm * 256 + i) * DFF + c] = (bf16_t)(pk & 0xffffu);
    }
}

DI void phase_final(PP p, const int tid) {
    const int lane = tid & 63, wave = tid >> 6; const float* ss = (const float*)(p->ws + WS_SS); const bf16_t* xb = (const bf16_t*)(p->ws + WS_XB);
    f32x4 g[4];
#pragma unroll
    for (int j = 0; j < 2; ++j) { g[2 * j] = *(const f32x4*)(p->final_norm_g + 8 * lane + 512 * j); g[2 * j + 1] = *(const f32x4*)(p->final_norm_g + 8 * lane + 512 * j + 4); }
    for (int row0 = (blockIdx.x * 8 + wave) * 4; row0 < T; row0 += gridDim.x * 8 * 4) {
        u32x4 xv[4][2]; float sr[4];
#pragma unroll
        for (int q = 0; q < 4; ++q) {
#pragma unroll
            for (int j = 0; j < 2; ++j) xv[q][j] = *(const u32x4*)(xb + (size_t)(row0 + q) * DM + 8 * lane + 512 * j);
            float s = 0.f;
#pragma unroll
            for (int pl = 0; pl < 16; ++pl) s += ss[(size_t)pl * T + row0 + q];
            sr[q] = rsqrtf(s * (1.f / DM) + EPS);
        }
#pragma unroll
        for (int q = 0; q < 4; ++q)
#pragma unroll
            for (int j = 0; j < 2; ++j) { const size_t o = (size_t)(row0 + q) * DM + 8 * lane + 512 * j; const u32x4 x4 = xv[q][j]; const float rs = sr[q];
                f32x4 v0 = {bf_lo(x4.x), bf_hi(x4.x), bf_lo(x4.y), bf_hi(x4.y)}, v1 = {bf_lo(x4.z), bf_hi(x4.z), bf_lo(x4.w), bf_hi(x4.w)};
                *(f32x4*)(p->out + o) = v0 * rs * g[2 * j]; *(f32x4*)(p->out + o + 4) = v1 * rs * g[2 * j + 1]; }
    }
}

#define XB_TMO      128
#define XB_XCNT(j)  (256  + 64 * (j))
#define XB_XSUB(j)  (1280 + 64 * (j))
#define XB_XGEN(j)  (2304 + 64 * (j))
#define XB_TOP      3328
#define XB_TOPGEN   3392
#define XCD_BAR_WORDS 3456
#define XB_SPIN_CAP (1u << 18)
DI unsigned xb_ld(unsigned* p)              { return __hip_atomic_load(p, __ATOMIC_RELAXED, __HIP_MEMORY_SCOPE_AGENT); }
DI unsigned xb_add(unsigned* p, unsigned v) { return __hip_atomic_fetch_add(p, v, __ATOMIC_RELAXED, __HIP_MEMORY_SCOPE_AGENT); }
DI unsigned xb_xcc_id() { return (unsigned)__builtin_amdgcn_s_getreg((3 << 11) | 20) & 0xFu; }
#define XB_SPIN(cond, bar) do { unsigned _sp = 0; while (cond) { __builtin_amdgcn_s_sleep(1); \
    if ((++_sp & 255u) == 0u) { if (xb_ld(&(bar)[XB_TMO])) break; if (_sp > XB_SPIN_CAP) { atomicAdd(&(bar)[XB_TMO], 1u); break; } } } } while (0)
struct XcdBarrier { unsigned* bar; unsigned x; volatile LAS unsigned* st; };
DI XcdBarrier xcd_barrier_post(unsigned* bar, volatile LAS unsigned* st) {
    XcdBarrier b; b.bar = bar; b.x = xb_xcc_id(); b.st = st;
    if (threadIdx.x == 0) (void)xb_add(&bar[XB_XCNT(b.x)], 1u);
    return b;
}
DI void xcd_barrier_complete(unsigned* bar, unsigned x, unsigned& nloc, unsigned& nx) {
    const unsigned G = gridDim.x * gridDim.y * gridDim.z;
    unsigned sum, cnt, mine, sp = 0u;
    for (;;) {
        sum = 0u; cnt = 0u; mine = 0u;
#pragma unroll
        for (unsigned j = 0; j < 16; ++j) { const unsigned c = xb_ld(&bar[XB_XCNT(j)]); sum += c; cnt += (c > 0u) ? 1u : 0u; mine = (j == x) ? c : mine; }
        if (sum == G) break;
        __builtin_amdgcn_s_sleep(1);
        if ((++sp & 255u) == 0u) { if (xb_ld(&bar[XB_TMO])) break; if (sp > XB_SPIN_CAP) { atomicAdd(&bar[XB_TMO], 1u); break; } }
    }
    nloc = mine > 0u ? mine : 1u; nx = cnt > 0u ? cnt : 1u;
}
DI void xcd_barrier(const XcdBarrier& b, const int tid) {
    asm volatile("s_waitcnt vmcnt(0)" ::: "memory");
    __syncthreads();
    if (tid == 0) {
        unsigned* bar = b.bar; asm volatile("" : "+s"(bar));
        __builtin_amdgcn_s_waitcnt(0);
        unsigned nloc = b.st[0], nx = b.st[1];
        if (nloc == 0u) { xcd_barrier_complete(bar, b.x, nloc, nx); b.st[0] = nloc; b.st[1] = nx; }
        const unsigned old = xb_add(&bar[XB_XSUB(b.x)], 1u);
        const unsigned gen = old / nloc;
        if (old + 1u == (gen + 1u) * nloc) {
            __builtin_amdgcn_fence(__ATOMIC_RELEASE, "agent");
            asm volatile("s_waitcnt vmcnt(0)" ::: "memory");
            const unsigned og = xb_add(&bar[XB_TOP], 1u);
            const unsigned tg = og / nx;
            if (og + 1u == (tg + 1u) * nx) xb_add(&bar[XB_TOPGEN], 1u);
            else XB_SPIN(xb_ld(&bar[XB_TOPGEN]) == tg, bar);
            __builtin_amdgcn_fence(__ATOMIC_ACQUIRE, "agent");
            xb_add(&bar[XB_XGEN(b.x)], 1u);
            asm volatile("s_waitcnt vmcnt(0)" ::: "memory");
        } else {
            XB_SPIN(xb_ld(&bar[XB_XGEN(b.x)]) == gen, bar);
            __builtin_amdgcn_fence(__ATOMIC_ACQUIRE, "agent");
            asm volatile("s_waitcnt vmcnt(0)" ::: "memory");
        }
    }
    __syncthreads();
}

__global__ __launch_bounds__(512, 2) void fwd_kernel(Params parg) {
    extern __shared__ __attribute__((aligned(16))) unsigned char shm[];
    LAS unsigned char* lds = (LAS unsigned char*)shm;
    const int ph_lo = parg.ph_lo, ph_hi = parg.ph_hi, coop = parg.coop;
    const int wave_id = __builtin_amdgcn_readfirstlane((int)(threadIdx.x >> 6));
    volatile LAS unsigned* xst = (volatile LAS unsigned*)(lds + XB_ST_OFF);
    if (threadIdx.x == 0) { xst[0] = 0u; xst[1] = 0u; xst[2] = 0u; xst[3] = 0u; }
    __syncthreads();
    XcdBarrier xb_; xb_.bar = (unsigned*)(parg.ws + WS_BAR); xb_.x = 0; xb_.st = xst;
    if (coop == 1) xb_ = xcd_barrier_post((unsigned*)(parg.ws + WS_BAR), xst);
#ifdef PROBE_REP
    for (int ph2 = ph_lo; ph2 < ph_hi + 1; ++ph2) {
        const int ph = ph2 <= PROBE_REP ? ph2 : ph2 - 1;
#else
    for (int ph = ph_lo; ph < ph_hi; ++ph) {
#endif
        int wv_ = wave_id; asm volatile("" : "+s"(wv_));
        int tid = wv_ * 64 + (int)__builtin_amdgcn_mbcnt_hi(~0u, __builtin_amdgcn_mbcnt_lo(~0u, 0u)); asm volatile("" : "+v"(tid));
        PP p = (PP)__builtin_amdgcn_kernarg_segment_ptr(); asm volatile("" : "+s"(p));
        unsigned char* ws = p->ws;
        bf16_t* xb = (bf16_t*)(ws + WS_XB); float* ss = (float*)(ws + WS_SS);
        StaticOrder S;
        if (ph == 0) phase_prep(p, lds, tid);
        else if (ph == NPHASE - 1) phase_final(p, tid);
        else {
            const int layer = (ph - 1) / 5, sub = (ph - 1) % 5;
            if (sub == 0) {
                Gemm g; g.A = xb; g.Bt = (const bf16_t*)(ws + WS_WIN + layer * SZ_WIN); g.M = T; g.N = DIN; g.K = DM;
                EpiProj E; E.O = (bf16_t*)(ws + WS_PROJ); E.ss = ss;
                S.init(g.M, g.N, (int)gridDim.x, (int)blockIdx.x);
                rstd_table(lds, S, ss, tid);
                gemm_phase<EpiProj>(lds, g, S, E, tid);
            } else if (sub == 1) {
                phase_mixer(p, layer, lds, tid);
            } else if (sub == 2 || sub == 4) {
                Gemm g; g.M = T; g.N = DM;
                if (sub == 2) { g.A = (const bf16_t*)(ws + WS_MIX); g.Bt = (const bf16_t*)(ws + WS_WOUT + layer * SZ_WOUT); g.K = DM; }
                else { g.A = (const bf16_t*)(ws + WS_PROJ); g.Bt = (const bf16_t*)(ws + WS_WDN + layer * SZ_WDN); g.K = DFF; }
                EpiRes E; E.xb = xb; E.ss = ss;
                S.init(g.M, g.N, (int)gridDim.x, (int)blockIdx.x);
                if (sub == 4) {
                    Unit u; for (int i = 0; S.next(i, u); ++i) fixup_tile(p, layer, tid, u.pm);
                    asm volatile("s_waitcnt vmcnt(0)" ::: "memory"); __syncthreads();
                }
                gemm_phase<EpiRes>(lds, g, S, E, tid);
            } else {
                Gemm g; g.A = xb; g.Bt = (const bf16_t*)(ws + WS_WUP + layer * SZ_WUP); g.M = T; g.N = DUP; g.K = DM;
                EpiUp E; E.act = (bf16_t*)(ws + WS_PROJ); E.ss = ss; E.cw = p->ffn_conv_w + (size_t)layer * 3 * DUP; E.H = (float*)(ws + WS_H);
                S.init(g.M, g.N, (int)gridDim.x, (int)blockIdx.x);
                gemm_phase<EpiUp>(lds, g, S, E, tid);
            }
        }
#ifdef PROBE_REP
        if (ph2 < ph_hi) { if (coop == 1) xcd_barrier(xb_, tid); else if (coop == 2) cg::this_grid().sync(); }
#else
        if (ph + 1 < ph_hi) { if (coop == 1) xcd_barrier(xb_, tid); else if (coop == 2) cg::this_grid().sync(); }
#endif
    }
}

extern "C" void kernel_launch(void* const* d_in, const int* in_sizes, int n_in, void* d_out, int out_size, void* d_ws, size_t ws_size, hipStream_t stream) {
    static int grid = 0;
    if (grid == 0) {
        if (n_in != 12 || out_size != T * DM || ws_size < WS_END) { fprintf(stderr, "kernel_launch: unexpected shapes (n_in %d out %d ws %zu need %zu)\n", n_in, out_size, ws_size, (size_t)WS_END); grid = -1; return; }
        int dev = 0, cus = 0, per_cu = 0;
        (void)hipGetDevice(&dev); (void)hipDeviceGetAttribute(&cus, hipDeviceAttributeMultiprocessorCount, dev);
        if (hipFuncSetAttribute((const void*)fwd_kernel, hipFuncAttributeMaxDynamicSharedMemorySize, LDS_BYTES) != hipSuccess) { fprintf(stderr, "hipFuncSetAttribute failed\n"); grid = -1; return; }
        (void)hipOccupancyMaxActiveBlocksPerMultiprocessor(&per_cu, (const void*)fwd_kernel, 512, LDS_BYTES);
        if (per_cu < 1) per_cu = 1;
        (void)hipGetLastError();
        grid = cus;
    }
    if (grid < 0) return;
    Params p{};
    p.x = (const float*)d_in[0]; p.norm1_g = (const float*)d_in[1]; p.w_in = (const float*)d_in[2]; p.mix_conv_w = (const float*)d_in[3];
    p.attn_out_g = (const float*)d_in[4]; p.conv_out_g = (const float*)d_in[5]; p.w_out = (const float*)d_in[6]; p.norm2_g = (const float*)d_in[7];
    p.ffn_up = (const float*)d_in[8]; p.ffn_conv_w = (const float*)d_in[9]; p.ffn_down = (const float*)d_in[10]; p.final_norm_g = (const float*)d_in[11];
    p.out = (float*)d_out; p.ws = (unsigned char*)d_ws; p.pad = 0;
#if defined(MULTI_LAUNCH)
    for (int ph = 0; ph < NPHASE; ++ph) { p.ph_lo = ph; p.ph_hi = ph + 1; p.coop = 0;
        hipLaunchKernelGGL(fwd_kernel, dim3(grid), dim3(512), LDS_BYTES, stream, p); }
#else
    p.ph_lo = 0; p.ph_hi = NPHASE; p.coop = 1;
    if (hipMemsetAsync((char*)d_ws + WS_BAR, 0, 16384, stream) != hipSuccess) { fprintf(stderr, "memset of barrier words failed\n"); return; }
    void* args[] = {&p};
    hipError_t e = hipLaunchCooperativeKernel((const void*)fwd_kernel, dim3(grid), dim3(512), args, LDS_BYTES, stream);
    if (e != hipSuccess) fprintf(stderr, "cooperative launch failed: %s (grid %d)\n", hipGetErrorString(e), grid);
#endif
}
```

```cpp
#include <hip/hip_runtime.h>
#include <hip/hip_cooperative_groups.h>
#include <cstdio>
namespace cg = cooperative_groups;

#define LAS __attribute__((address_space(3)))
#define DI __device__ __forceinline__
typedef unsigned short bf16_t;
typedef short bf16x8 __attribute__((ext_vector_type(8)));
typedef short s16x4 __attribute__((ext_vector_type(4)));
typedef float f32x2 __attribute__((ext_vector_type(2)));
typedef float f32x4 __attribute__((ext_vector_type(4)));
typedef float f32x16 __attribute__((ext_vector_type(16)));
typedef unsigned u32x2 __attribute__((ext_vector_type(2)));
typedef unsigned u32x4 __attribute__((ext_vector_type(4)));
typedef __bf16 bf16v2 __attribute__((ext_vector_type(2)));

constexpr int T = 32768, SEQ = 2048, DM = 1024, DIN = 3072, DFF = 2816, DUP = 5632, NL = 2;
constexpr float EPS = 1e-6f;
constexpr int BM = 256, BK = 64, HALF = 128, HTB = HALF * BK * 2, STAGE_BYTES = 8 * HTB, NXCD = 8, WGM = 4;
constexpr int XCH_OFF = STAGE_BYTES, XB_ST_OFF = STAGE_BYTES + 2048, RST_OFF = STAGE_BYTES + 4096, LDS_BYTES = STAGE_BYTES + 4096 + 12 * 1024;
constexpr int NPHASE = 12;

constexpr size_t SZ_WIN = (size_t)DIN * DM * 2, SZ_WOUT = (size_t)DM * DM * 2, SZ_WUP = (size_t)DUP * DM * 2, SZ_WDN = (size_t)DM * DFF * 2;
constexpr size_t WS_WIN = 0, WS_WOUT = WS_WIN + NL * SZ_WIN, WS_WUP = WS_WOUT + NL * SZ_WOUT, WS_WDN = WS_WUP + NL * SZ_WUP;
constexpr size_t WS_XB = WS_WDN + NL * SZ_WDN;
constexpr size_t WS_PROJ = WS_XB + (size_t)T * DM * 2;
constexpr size_t WS_MIX = WS_PROJ + (size_t)T * DIN * 2;
constexpr size_t WS_SS = WS_MIX + (size_t)T * DM * 2;
constexpr size_t WS_H = WS_SS + (size_t)16 * T * 4;
constexpr size_t WS_BAR = WS_H + (size_t)128 * 4 * DUP * 4;
constexpr size_t WS_END = WS_BAR + 16384;

struct Params;
typedef const __attribute__((address_space(4))) Params* PP;
struct Params {
    const float* x; const float* norm1_g; const float* w_in; const float* mix_conv_w; const float* attn_out_g; const float* conv_out_g;
    const float* w_out; const float* norm2_g; const float* ffn_up; const float* ffn_conv_w; const float* ffn_down; const float* final_norm_g;
    float* out; unsigned char* ws; int ph_lo, ph_hi, coop, pad;
};

DI unsigned pk2(float a, float b) { f32x2 v = {a, b}; bf16v2 r = __builtin_convertvector(v, bf16v2); return __builtin_bit_cast(unsigned, r); }
DI float bf_lo(unsigned u) { return __uint_as_float(u << 16); }
DI float bf_hi(unsigned u) { return __uint_as_float(u & 0xffff0000u); }
DI float xor16_32(float v) { v += __shfl_xor(v, 16); v += __shfl_xor(v, 32); return v; }

__host__ __device__ __forceinline__ int lds_byte(int r, int c) { const int st = (r >> 4) * 2 + (c >> 5), rr = r & 15, cc = c & 31, ob = rr * 64 + cc * 2; return st * 1024 + (ob ^ (((ob >> 9) & 1) << 5)); }
__host__ __device__ __forceinline__ void stage_rc(int b, int& R, int& C) { const int st = b / 1024, sb = b % 1024, swz = sb ^ (((sb >> 9) & 1) << 5); R = (st >> 1) * 16 + swz / 64; C = (st & 1) * 32 + (swz % 64) / 2; }
__host__ __device__ __forceinline__ int perm32(int rho) { const int n = rho >> 4, i = rho & 15; return 8 * (i >> 2) + 4 * n + (i & 3); }

struct Unit { int pm, pn; };
struct Gemm { const bf16_t* A; const bf16_t* Bt; int M, N, K; };
struct StaticOrder {
    int nM, nN, nwg, G, c;
    DI void init(int M, int N, int G_, int c_) { nM = M / BM; nN = N / BM; nwg = nM * nN; G = G_; c = c_; }
    DI bool next(int i, Unit& u) const {
        const long L = (long)i * G + c; if (L >= nwg) return false;
        int wgid = (int)L; { const int q = nwg / NXCD, r = nwg % NXCD, xcd = wgid % NXCD, off = wgid / NXCD; wgid = (xcd < r ? xcd * (q + 1) : r * (q + 1) + (xcd - r) * q) + off; }
        const int nig = WGM * nN, gid = wgid / nig, fm = gid * WGM, gsz = (nM - fm) < WGM ? (nM - fm) : WGM;
        u.pm = fm + ((wgid % nig) % gsz); u.pn = (wgid % nig) / gsz; return true;
    }
};


DI float row_rstd(const float* ss, int row, int fq) {
    const float* p = ss + (size_t)(4 * fq) * T + row;
    float s = (p[0] + p[T]) + (p[2 * T] + p[3 * T]);
    s = xor16_32(s);
    return rsqrtf(s * (1.f / DM) + EPS);
}

struct EpiProj {
    static constexpr bool PERM = true, ROWPERM = false;
    bf16_t* O; const float* ss;
    DI void operator()(f32x4 (&acc)[2][2][4][2], const Unit& u, int wr, int wc, int fr, int fq, LAS unsigned char* lds, int ui) const {
        const int row0 = u.pm * BM + wr * 64 + fr, col0 = u.pn * BM + wc * 32 + 8 * fq;
#pragma unroll
        for (int ai = 0; ai < 2; ++ai)
#pragma unroll
            for (int m = 0; m < 4; ++m) {
                const int row = row0 + ai * HALF + m * 16; const float rs = ((const LAS float*)(lds + RST_OFF))[ui * 256 + ai * HALF + wr * 64 + m * 16 + fr];
                bf16_t* rowp = O + (size_t)row * DIN + col0;
#pragma unroll
                for (int bj = 0; bj < 2; ++bj) { const f32x4 v0 = acc[ai][bj][m][0] * rs, v1 = acc[ai][bj][m][1] * rs;
                    u32x4 w; w.x = pk2(v0[0], v0[1]); w.y = pk2(v0[2], v0[3]); w.z = pk2(v1[0], v1[1]); w.w = pk2(v1[2], v1[3]);
                    *(u32x4*)(rowp + bj * HALF) = w; }
                asm volatile("" ::: "memory");
            }
    }
};

struct EpiRes {
    static constexpr bool PERM = true, ROWPERM = false;
    bf16_t* xb; float* ss;
    DI void operator()(f32x4 (&acc)[2][2][4][2], const Unit& u, int wr, int wc, int fr, int fq, LAS unsigned char* lds, int ui) const {
        const int row0 = u.pm * BM + wr * 64 + fr, col0 = u.pn * BM + wc * 32 + 8 * fq;
#pragma unroll
        for (int ai = 0; ai < 2; ++ai) {
            u32x4 xv[4][2];
#pragma unroll
            for (int m = 0; m < 4; ++m)
#pragma unroll
                for (int bj = 0; bj < 2; ++bj) xv[m][bj] = *(const u32x4*)(xb + (size_t)(row0 + ai * HALF + m * 16) * DM + col0 + bj * HALF);
            float sq[4];
#pragma unroll
            for (int m = 0; m < 4; ++m) {
                bf16_t* rowp = xb + (size_t)(row0 + ai * HALF + m * 16) * DM + col0; float q = 0.f;
#pragma unroll
                for (int bj = 0; bj < 2; ++bj) {
                    const u32x4 x4 = xv[m][bj];
                    const f32x4 a0 = acc[ai][bj][m][0], a1 = acc[ai][bj][m][1];
                    u32x4 w; w.x = pk2(bf_lo(x4.x) + a0[0], bf_hi(x4.x) + a0[1]); w.y = pk2(bf_lo(x4.y) + a0[2], bf_hi(x4.y) + a0[3]);
                    w.z = pk2(bf_lo(x4.z) + a1[0], bf_hi(x4.z) + a1[1]); w.w = pk2(bf_lo(x4.w) + a1[2], bf_hi(x4.w) + a1[3]);
                    *(u32x4*)(rowp + bj * HALF) = w;
                    q += (bf_lo(w.x) * bf_lo(w.x) + bf_hi(w.x) * bf_hi(w.x)) + (bf_lo(w.y) * bf_lo(w.y) + bf_hi(w.y) * bf_hi(w.y))
                       + (bf_lo(w.z) * bf_lo(w.z) + bf_hi(w.z) * bf_hi(w.z)) + (bf_lo(w.w) * bf_lo(w.w) + bf_hi(w.w) * bf_hi(w.w));
                }
                sq[m] = q;
            }
#pragma unroll
            for (int m = 0; m < 4; ++m) { const float q = xor16_32(sq[m]); if (fq == 0) ss[(size_t)(u.pn * 4 + wc) * T + row0 + ai * HALF + m * 16] = q; }
            asm volatile("" ::: "memory");
        }
    }
};

DI float dpp_shr1(float v) { return __int_as_float(__builtin_amdgcn_update_dpp(0, __float_as_int(v), 0x111, 0xf, 0xf, true)); }
DI float silu_mul(float g, float v) { return g * v * __builtin_amdgcn_rcpf(1.f + __builtin_amdgcn_exp2f(-1.44269504089f * g)); }

struct EpiUp {
    static constexpr bool PERM = true, ROWPERM = true;
    bf16_t* act; const float* ss; const float* cw; float* H;
    DI void operator()(f32x4 (&acc)[2][2][4][2], const Unit& u, int wr, int wc, int fr, int fq, LAS unsigned char* lds, int ui) const {
        const int row0 = u.pm * BM + wr * 128 + fr * 8;
        const int ct = wc * 32 + 8 * fq;
        {
            float s8[8];
#pragma unroll
            for (int i = 0; i < 8; ++i) s8[i] = 0.f;
#pragma unroll
            for (int pl = 0; pl < 4; ++pl) { const float* p = ss + (size_t)(4 * fq + pl) * T + row0; const f32x4 a = *(const f32x4*)p, b = *(const f32x4*)(p + 4);
#pragma unroll
                for (int i = 0; i < 4; ++i) { s8[i] += a[i]; s8[4 + i] += b[i]; } }
#pragma unroll
            for (int i = 0; i < 8; ++i) { const float rs = rsqrtf(xor16_32(s8[i]) * (1.f / DM) + EPS);
#pragma unroll
                for (int bj = 0; bj < 2; ++bj)
#pragma unroll
                    for (int n = 0; n < 2; ++n) acc[i >> 2][bj][i & 3][n] *= rs; }
        }
        LAS float* xch = (LAS float*)(lds + XCH_OFF);
        if (fr == 0 && wr == 0) {
#pragma unroll
            for (int k = 0; k < 2; ++k)
#pragma unroll
                for (int bj = 0; bj < 2; ++bj)
#pragma unroll
                    for (int n = 0; n < 2; ++n) *(f32x4*)(H + ((size_t)u.pm * 4 + k) * DUP + u.pn * BM + bj * HALF + ct + 4 * n) = acc[0][bj][k][n];
        }
        if (fr == 15) {
            if (wr == 1) {
#pragma unroll
                for (int k = 0; k < 2; ++k)
#pragma unroll
                    for (int bj = 0; bj < 2; ++bj)
#pragma unroll
                        for (int n = 0; n < 2; ++n) *(f32x4*)(H + ((size_t)u.pm * 4 + 2 + k) * DUP + u.pn * BM + bj * HALF + ct + 4 * n) = acc[1][bj][2 + k][n];
            } else {
#pragma unroll
                for (int k = 0; k < 2; ++k)
#pragma unroll
                    for (int bj = 0; bj < 2; ++bj)
#pragma unroll
                        for (int n = 0; n < 2; ++n) *(LAS f32x4*)(xch + ((wc * 4 + fq) * 2 + k) * 16 + (bj * 2 + n) * 4) = acc[1][bj][2 + k][n];
            }
        }
        asm volatile("s_waitcnt lgkmcnt(0)" ::: "memory");
        __builtin_amdgcn_s_barrier();
        asm volatile("" ::: "memory");
        const size_t cwc = (size_t)u.pn * 128 + ct;
#pragma unroll
        for (int n = 0; n < 2; ++n) {
            f32x4 w[2][3];
#pragma unroll
            for (int bj = 0; bj < 2; ++bj)
#pragma unroll
                for (int k = 0; k < 3; ++k) w[bj][k] = *(const f32x4*)(cw + (size_t)k * DUP + bj * DFF + cwc + 4 * n);
#pragma unroll
            for (int bj = 0; bj < 2; ++bj) {
                f32x4 h1, h2;
#pragma unroll
                for (int e = 0; e < 4; ++e) { h1[e] = dpp_shr1(acc[1][bj][3][n][e]); h2[e] = dpp_shr1(acc[1][bj][2][n][e]); }
                if (fr == 0) {
                    if (wr == 1) { h2 = *(LAS f32x4*)(xch + ((wc * 4 + fq) * 2 + 0) * 16 + (bj * 2 + n) * 4); h1 = *(LAS f32x4*)(xch + ((wc * 4 + fq) * 2 + 1) * 16 + (bj * 2 + n) * 4); }
                    else { h1 = (f32x4){0.f, 0.f, 0.f, 0.f}; h2 = h1; }
                }
#pragma unroll
                for (int i = 7; i >= 0; --i) {
                    const f32x4 p0 = acc[i >> 2][bj][i & 3][n];
                    const f32x4 p1 = (i >= 1) ? acc[(i - 1) >> 2][bj][(i - 1) & 3][n] : h1;
                    const f32x4 p2 = (i >= 2) ? acc[(i - 2) >> 2][bj][(i - 2) & 3][n] : (i == 1 ? h1 : h2);
                    acc[i >> 2][bj][i & 3][n] = w[bj][2] * p0 + w[bj][1] * p1 + w[bj][0] * p2;
                }
            }
#pragma unroll
            for (int i = 0; i < 8; ++i)
#pragma unroll
                for (int e = 0; e < 4; ++e) acc[i >> 2][0][i & 3][n][e] = silu_mul(acc[i >> 2][0][i & 3][n][e], acc[i >> 2][1][i & 3][n][e]);
            asm volatile("" ::: "memory");
        }
#pragma unroll
        for (int i = 0; i < 8; ++i) { const f32x4 v0 = acc[i >> 2][0][i & 3][0], v1 = acc[i >> 2][0][i & 3][1];
            u32x4 o; o.x = pk2(v0[0], v0[1]); o.y = pk2(v0[2], v0[3]); o.z = pk2(v1[0], v1[1]); o.w = pk2(v1[2], v1[3]);
            *(u32x4*)(act + (size_t)(row0 + i) * DFF + cwc) = o; asm volatile("" ::: "memory"); }
    }
};

DI void rstd_table(LAS unsigned char* lds, const StaticOrder& S, const float* __restrict__ ss, const int tid) {
    LAS float* rt = (LAS float*)(lds + RST_OFF);
    const int row = tid & 255, par = tid >> 8;
    Unit u;
    for (int i = par; S.next(i, u); i += 2) {
        const float* p = ss + (size_t)u.pm * BM + row; float s = 0.f;
#pragma unroll
        for (int pl = 0; pl < 16; ++pl) s += p[(size_t)pl * T];
        rt[i * 256 + row] = rsqrtf(s * (1.f / DM) + EPS);
    }
    __syncthreads();
}

template <class Epi>
DI void gemm_phase(LAS unsigned char* lds, const Gemm g, const StaticOrder& S, const Epi& E, const int tid) {
    const int wid = __builtin_amdgcn_readfirstlane(tid >> 6), lane = tid & 63, wr = wid >> 2, wc = wid & 3, fr = lane & 15, fq = lane >> 4;
    const int K = g.K, nt = K / BK;
    unsigned voffA[2], voffB[2];
#pragma unroll
    for (int i = 0; i < 2; ++i) { int R, C; stage_rc(tid * 16 + i * 8192, R, C); const int Rb = Epi::PERM ? ((R & ~31) + perm32(R & 31)) : R;
        voffB[i] = (unsigned)(Rb * K + C) * 2u;
        const int Ra = Epi::ROWPERM ? (128 * (R >> 6) + 8 * (R & 15) + ((R >> 4) & 3)) : R;
        voffA[i] = (unsigned)(Ra * K + C) * 2u; }
    const size_t kstep = (size_t)(BK * 2);
    const size_t hstep = (size_t)HALF * K * 2;
    const size_t tstep = 2 * hstep;
    const size_t astep = Epi::ROWPERM ? (size_t)4 * K * 2 : hstep;
    const unsigned ldsw = (unsigned)wid * 1024u;
    const int aoff = lds_byte(wr * 64 + fr, fq * 8), boff = lds_byte(wc * 32 + fr, fq * 8);
#define PG8_SA(b, h) (((b) * 2 + (h)) * HTB)
#define PG8_SB(b, h) ((4 + (b) * 2 + (h)) * HTB)
#define PG8_STAGE(bufoff, gbase, voff) do { _Pragma("unroll") for (int _i = 0; _i < 2; ++_i) \
        __builtin_amdgcn_global_load_lds((const unsigned*)((const char*)(gbase) + (voff)[_i]), (LAS unsigned*)(lds + (bufoff) + ldsw + _i * 8192), 16, 0, 0); } while (0)
#define PG8_LDA(dst, b, h) do { _Pragma("unroll") for (int m = 0; m < 4; ++m) _Pragma("unroll") for (int k = 0; k < 2; ++k) dst[m][k] = *(const LAS bf16x8*)(lds + PG8_SA(b, h) + aoff + m * 2048 + k * 1024); } while (0)
#define PG8_LDB(dst, b, h) do { _Pragma("unroll") for (int n = 0; n < 2; ++n) _Pragma("unroll") for (int k = 0; k < 2; ++k) dst[n][k] = *(const LAS bf16x8*)(lds + PG8_SB(b, h) + boff + n * 2048 + k * 1024); } while (0)
#define PG8_MMA(ai, bj, At, Bt) do { __builtin_amdgcn_s_setprio(1); _Pragma("unroll") for (int m = 0; m < 4; ++m) _Pragma("unroll") for (int n = 0; n < 2; ++n) _Pragma("unroll") for (int k = 0; k < 2; ++k) \
        acc[ai][bj][m][n] = __builtin_amdgcn_mfma_f32_16x16x32_bf16(Bt[n][k], At[m][k], acc[ai][bj][m][n], 0, 0, 0); __builtin_amdgcn_s_setprio(0); } while (0)
#define PG8_WAIT_V(n) asm volatile("s_waitcnt vmcnt(" #n ")" ::: "memory")
#define PG8_WAIT_L(n) asm volatile("s_waitcnt lgkmcnt(" #n ")" ::: "memory")
#define PG8_BAR __builtin_amdgcn_s_barrier()
#define PG8_SCHED __builtin_amdgcn_sched_barrier(0)
    Unit cur, nxt; int ui = 0;
    if (!S.next(0, cur)) return;
    f32x4 acc[2][2][4][2];
#pragma unroll
    for (int a = 0; a < 2; ++a)
#pragma unroll
        for (int b = 0; b < 2; ++b)
#pragma unroll
            for (int m = 0; m < 4; ++m)
#pragma unroll
                for (int n = 0; n < 2; ++n) acc[a][b][m][n] = (f32x4){0.f, 0.f, 0.f, 0.f};
    bf16x8 At[4][2], B0[2][2], B1[2][2];
    const char* cA = (const char*)g.A + (size_t)cur.pm * tstep; const char* cB = (const char*)g.Bt + (size_t)cur.pn * tstep;
    PG8_STAGE(PG8_SB(0, 0), cB, voffB); PG8_STAGE(PG8_SB(0, 1), cB + hstep, voffB); PG8_STAGE(PG8_SA(0, 0), cA, voffA); PG8_STAGE(PG8_SA(0, 1), cA + astep, voffA);
    if (wr == 1) PG8_BAR;
    PG8_WAIT_V(2); PG8_BAR;
    PG8_STAGE(PG8_SB(1, 0), cB + kstep, voffB); PG8_STAGE(PG8_SA(1, 0), cA + kstep, voffA); PG8_STAGE(PG8_SB(1, 1), cB + hstep + kstep, voffB);
    PG8_WAIT_V(6); PG8_BAR;
    for (;;) {
        const bool has_next = S.next(ui + 1, nxt);
        const char* nA = has_next ? (const char*)g.A + (size_t)nxt.pm * tstep : cA; const char* nB = has_next ? (const char*)g.Bt + (size_t)nxt.pn * tstep : cB;
        for (int t = 0; t < nt; t += 2) {
            const bool last = (t == nt - 2);
            const char* a1 = cA + (size_t)(t + 1) * kstep;
            const char* a2 = last ? nA : cA + (size_t)(t + 2) * kstep; const char* b2 = last ? nB : cB + (size_t)(t + 2) * kstep;
            const char* a3 = a2 + kstep; const char* b3 = b2 + kstep;
            PG8_LDB(B0, 0, 0); PG8_LDB(B1, 0, 1); PG8_SCHED; PG8_LDA(At, 0, 0); PG8_STAGE(PG8_SA(1, 1), a1 + astep, voffA);
            PG8_WAIT_V(8); PG8_WAIT_L(0); PG8_BAR; PG8_MMA(0, 0, At, B0); PG8_MMA(0, 1, At, B1); PG8_BAR; PG8_SCHED;
            PG8_LDA(At, 0, 1); PG8_STAGE(PG8_SB(0, 0), b2, voffB); PG8_STAGE(PG8_SB(0, 1), b2 + hstep, voffB); PG8_STAGE(PG8_SA(0, 0), a2, voffA);
            PG8_WAIT_V(8); PG8_WAIT_L(0); PG8_BAR; PG8_MMA(1, 0, At, B0); PG8_MMA(1, 1, At, B1); PG8_BAR; PG8_SCHED;
            PG8_LDB(B0, 1, 0); PG8_LDB(B1, 1, 1); PG8_SCHED; PG8_LDA(At, 1, 0); PG8_STAGE(PG8_SA(0, 1), a2 + astep, voffA);
            PG8_WAIT_V(8); PG8_WAIT_L(0); PG8_BAR; PG8_MMA(0, 0, At, B0); PG8_MMA(0, 1, At, B1); PG8_BAR; PG8_SCHED;
            PG8_LDA(At, 1, 1); PG8_STAGE(PG8_SB(1, 0), b3, voffB); PG8_STAGE(PG8_SB(1, 1), b3 + hstep, voffB); PG8_STAGE(PG8_SA(1, 0), a3, voffA);
            PG8_WAIT_V(8); PG8_WAIT_L(0); PG8_BAR; PG8_MMA(1, 0, At, B0); PG8_MMA(1, 1, At, B1); PG8_BAR; PG8_SCHED;
        }
        if (wr == 0) PG8_BAR;
        { int fr2 = fr, fq2 = fq; asm volatile("" : "+v"(fr2), "+v"(fq2));
          E(acc, cur, wr, wc, fr2, fq2, lds, ui); }
        if (!has_next) break;
#pragma unroll
        for (int a = 0; a < 2; ++a)
#pragma unroll
            for (int b = 0; b < 2; ++b)
#pragma unroll
                for (int m = 0; m < 4; ++m)
#pragma unroll
                    for (int n = 0; n < 2; ++n) acc[a][b][m][n] = (f32x4){0.f, 0.f, 0.f, 0.f};
        cur = nxt; cA = nA; cB = nB; ++ui;
        if (wr == 1) PG8_BAR;
    }
    PG8_WAIT_V(0);
    PG8_BAR;
#undef PG8_SA
#undef PG8_SB
#undef PG8_STAGE
#undef PG8_LDA
#undef PG8_LDB
#undef PG8_MMA
#undef PG8_WAIT_V
#undef PG8_WAIT_L
#undef PG8_BAR
#undef PG8_SCHED
}

struct WItem { const float* W; const float* g; bf16_t* WT; int K, N, k0, n0, drow0; };
DI void transpose_load(const WItem& w, float (&v)[32], int lane) {
    const float* rb = w.W + (size_t)w.k0 * w.N + w.n0;
    const unsigned lo = (unsigned)(lane >> 5) * (unsigned)w.N + (unsigned)(lane & 31), hl = (unsigned)(lane >> 5);
    const float* gb = w.g ? w.g + w.k0 : nullptr;
#pragma unroll
    for (int i = 0; i < 32; ++i) { const float gv = gb ? gb[hl + 2u * i] : 1.f;
        v[i] = rb[lo + (unsigned)(2 * i) * (unsigned)w.N] * gv; }
}
DI void transpose_finish(const WItem& w, const float (&v)[32], LAS float* scr, int lane) {
#pragma unroll
    for (int i = 0; i < 32; ++i) scr[(2 * i + (lane >> 5)) * 33 + (lane & 31)] = v[i];
    asm volatile("s_waitcnt lgkmcnt(0)" ::: "memory");
    const int c = lane & 7;
#pragma unroll
    for (int j = 0; j < 4; ++j) { const int n = (lane >> 3) + 8 * j; const LAS float* sp = scr + (8 * c) * 33 + n;
        u32x4 o; o.x = pk2(sp[0], sp[33]); o.y = pk2(sp[2 * 33], sp[3 * 33]); o.z = pk2(sp[4 * 33], sp[5 * 33]); o.w = pk2(sp[6 * 33], sp[7 * 33]);
        *(u32x4*)(w.WT + (size_t)(w.drow0 + n) * w.K + w.k0 + 8 * c) = o; }
    asm volatile("s_waitcnt lgkmcnt(0)" ::: "memory");
}

constexpr int I_IN = 16 * 96, I_OUT = 16 * 32, I_UP = 16 * 176, I_DN = 44 * 32, I_L = I_IN + I_OUT + I_UP + I_DN;
DI WItem weight_desc(PP p, int it) {
    WItem w; const int l = it / I_L; int r = it % I_L;
    if (r < I_IN) { const int kb = r / 96, nb = r % 96;
        w.W = p->w_in + (size_t)l * DM * DIN; w.g = p->norm1_g + l * DM; w.K = DM; w.N = DIN; w.WT = (bf16_t*)(p->ws + WS_WIN + l * SZ_WIN); w.k0 = kb * 64; w.n0 = nb * 32; w.drow0 = nb * 32; return w; }
    r -= I_IN;
    if (r < I_OUT) { const int kb = r / 32, nb = r % 32;
        w.W = p->w_out + (size_t)l * DM * DM; w.g = nullptr; w.K = DM; w.N = DM; w.WT = (bf16_t*)(p->ws + WS_WOUT + l * SZ_WOUT); w.k0 = kb * 64; w.n0 = nb * 32; w.drow0 = nb * 32; return w; }
    r -= I_OUT;
    if (r < I_UP) { const int kb = r / 176, nb = r % 176; const int n0 = nb * 32;
        const int drow = (n0 < DFF) ? ((n0 / 128) * 256 + (n0 % 128)) : (((n0 - DFF) / 128) * 256 + 128 + ((n0 - DFF) % 128));
        w.W = p->ffn_up + (size_t)l * DM * DUP; w.g = p->norm2_g + l * DM; w.K = DM; w.N = DUP; w.WT = (bf16_t*)(p->ws + WS_WUP + l * SZ_WUP); w.k0 = kb * 64; w.n0 = n0; w.drow0 = drow; return w; }
    r -= I_UP;
    { const int kb = r / 32, nb = r % 32;
        w.W = p->ffn_down + (size_t)l * DFF * DM; w.g = nullptr; w.K = DFF; w.N = DM; w.WT = (bf16_t*)(p->ws + WS_WDN + l * SZ_WDN); w.k0 = kb * 64; w.n0 = nb * 32; w.drow0 = nb * 32; return w; }
}
DI void weight_item(PP p, int it, LAS float* scr, int lane) { const WItem w = weight_desc(p, it); float v[32]; transpose_load(w, v, lane); transpose_finish(w, v, scr, lane); }
DI void weight_item2(PP p, int it0, int it1, bool has1, LAS float* scr, int lane) {
    const WItem w0 = weight_desc(p, it0), w1 = weight_desc(p, has1 ? it1 : it0);
    float v0[32], v1[32];
    transpose_load(w0, v0, lane); transpose_load(w1, v1, lane);
    transpose_finish(w0, v0, scr, lane);
    if (has1) transpose_finish(w1, v1, scr, lane);
}

DI void phase_prep(PP p, LAS unsigned char* lds, const int tid) {
    const int lane = tid & 63, wave = __builtin_amdgcn_readfirstlane(tid >> 6);
    const int gw = blockIdx.x * 8 + wave, NGW = gridDim.x * 8;
    {
        bf16_t* xb = (bf16_t*)(p->ws + WS_XB); float* ss = (float*)(p->ws + WS_SS); const float* x = p->x;
        for (int row0 = gw * 4; row0 < T; row0 += NGW * 4) {
            f32x4 xa[4][2], xc[4][2];
#pragma unroll
            for (int q = 0; q < 4; ++q)
#pragma unroll
                for (int j = 0; j < 2; ++j) { const size_t o = (size_t)(row0 + q) * DM + 8 * lane + 512 * j; xa[q][j] = *(const f32x4*)(x + o); xc[q][j] = *(const f32x4*)(x + o + 4); }
#pragma unroll
            for (int q = 0; q < 4; ++q) {
                float sq = 0.f;
#pragma unroll
                for (int j = 0; j < 2; ++j) { const size_t o = (size_t)(row0 + q) * DM + 8 * lane + 512 * j; const f32x4 a = xa[q][j], b = xc[q][j];
                    u32x4 w; w.x = pk2(a[0], a[1]); w.y = pk2(a[2], a[3]); w.z = pk2(b[0], b[1]); w.w = pk2(b[2], b[3]);
                    *(u32x4*)(xb + o) = w;
                    sq += (bf_lo(w.x) * bf_lo(w.x) + bf_hi(w.x) * bf_hi(w.x)) + (bf_lo(w.y) * bf_lo(w.y) + bf_hi(w.y) * bf_hi(w.y))
                        + (bf_lo(w.z) * bf_lo(w.z) + bf_hi(w.z) * bf_hi(w.z)) + (bf_lo(w.w) * bf_lo(w.w) + bf_hi(w.w) * bf_hi(w.w)); }
#pragma unroll
                for (int o = 1; o < 64; o <<= 1) sq += __shfl_xor(sq, o);
                if (lane < 16) ss[(size_t)lane * T + row0 + q] = (lane == 0) ? sq : 0.f;
            }
        }
    }
    LAS float* scr = (LAS float*)(lds + wave * 8448);
    for (int it = gw; it < I_IN; it += NGW) weight_item(p, it, scr, lane);
}

struct KV { u32x4 k[4]; u32x4 v[4]; };
constexpr int NT = 23;
DI bool tile_desc(int tt, int p0, int& kbase, int& kstride, int& W, int& cls) {
    if (tt < 8) { kstride = 1; kbase = p0 - 128 + 32 * tt; W = 128; cls = -1; }
    else if (tt < 11) { kstride = 4; kbase = p0 - 512 + 128 * (tt - 8); W = 512; cls = 0; }
    else { kstride = 4; kbase = p0 - 640 - 128 * (tt - 11); W = 2048; cls = 1; }
    return kbase + kstride * 31 >= 0;
}
DI int next_tile(int tt, int p0) { int kb, ks, W, cls; for (++tt; tt < NT; ++tt) if (tile_desc(tt, p0, kb, ks, W, cls)) break; return tt; }
DI void load_kv_at(KV& t, const bf16_t* __restrict__ base, int h, int kbase, int kstride, int vrow0, int vch) {
#pragma unroll
    for (int i = 0; i < 4; ++i) { int vpos = kbase + kstride * (vrow0 + 8 * i); vpos = vpos < 0 ? 0 : vpos;
        const bf16_t* rp = base + (size_t)vpos * DIN + h * 64 + 8 * vch;
        t.k[i] = *(const u32x4*)(rp + 512); t.v[i] = *(const u32x4*)(rp + 1024); }
}
DI void load_kv(KV& t, const bf16_t* __restrict__ base, int h, int tt, int p0, const bf16_t* __restrict__ nbase, int nh, int np0, int vrow0, int vch) {
    const bool here = tt < NT;
    int kbase, kstride, W, cls; tile_desc(here ? tt : next_tile(-1, np0), here ? p0 : np0, kbase, kstride, W, cls);
    load_kv_at(t, here ? base : nbase, here ? h : nh, kbase, kstride, vrow0, vch);
}

struct AttnState { float mrun, lrun; f32x16 o0, o1; };

DI void attn_tile(AttnState& st, const KV& t, const bf16x8 (&qf)[4], int tt, int p0, int qpos, int r, int hh, int vrow0, int vch, LAS unsigned char* vptr, unsigned ta0, unsigned ta1, float slope2, float sc) {
    int kbase, kstride, W, cls; tile_desc(tt, p0, kbase, kstride, W, cls);
#pragma unroll
    for (int i = 0; i < 4; ++i) { const int vr = vrow0 + 8 * i;
        *(LAS u32x4*)(vptr + 4096 + vr * 128 + ((vch ^ (vr & 7)) << 4)) = t.k[i];
        *(LAS u32x4*)(vptr + vr * 128 + ((vch * 16) ^ (((vr >> 1) & 1) << 6))) = t.v[i]; }
    bf16x8 kf[4];
#pragma unroll
    for (int c = 0; c < 4; ++c) kf[c] = *(const LAS bf16x8*)(vptr + 4096 + r * 128 + (((2 * c + hh) ^ (r & 7)) << 4));
    f32x16 S;
#pragma unroll
    for (int i = 0; i < 16; ++i) S[i] = 0.f;
#pragma unroll
    for (int c = 0; c < 4; ++c) S = __builtin_amdgcn_mfma_f32_32x32x16_bf16(kf[c], qf[c], S, 0, 0, 0);
#define SC_(x) asm("" : "+v"(x))
    const float dist0 = (float)(qpos - kbase - kstride * 4 * hh), nks = -(float)kstride, nsl = -slope2;
    float sv[16];
    float tmax = -3.0e38f;
    if (cls < 0) {
        const float half = 0.5f * (float)(qpos < W ? qpos : W), dpb = dist0 - half, K0 = -slope2 * half;
        const float hq = 0.5f * (float)qpos;
        const int e3 = (r - hh) & 3; const bool pe0 = e3 == 0, pe2 = e3 == 2;
#pragma unroll
        for (int i = 0; i < 16; ++i) { const float cf = (float)((i & 3) + 8 * (i >> 2));
            float dp = __builtin_fmaf(nks, cf, dpb);
            SC_(dp);
            float sx = __builtin_fmaf(S[i], sc, __builtin_fmaf(dp, nsl, K0));
            const bool v1 = __builtin_fabsf(dp) <= half;
            if ((i & 3) == 0) {
                const bool v4 = __builtin_fabsf(dp + (half - hq)) <= hq;
                const bool v16 = (((i >> 2) & 1) ? pe2 : pe0) && v4;
                const float add = v1 ? (v16 ? 1.5849625f : 1.f) : (v16 ? 1.f : 0.f);
                sx = v4 ? sx + add : -3.0e38f;
            } else sx = v1 ? sx : -3.0e38f;
            SC_(sx);
            sv[i] = sx; tmax = fmaxf(tmax, sx); }
    } else {
        const float hA = (cls == 0) ? 0.5f * (float)(qpos < 512 ? qpos : 512) : -1.f;
        const float hB = 0.5f * (float)qpos;
        const int rc = r & 3;
#pragma unroll
        for (int i = 0; i < 16; ++i) { const float cf = (float)((i & 3) + 8 * (i >> 2));
            float dist = __builtin_fmaf(nks, cf, dist0);
            SC_(dist);
            const bool vA = __builtin_fabsf(dist - hA) <= hA;
            const bool vB = (rc == (i & 3)) && (__builtin_fabsf(dist - hB) <= hB);
            float sx = __builtin_fmaf(S[i], sc, dist * nsl);
            sx += (vA && vB) ? 1.f : 0.f;
            sx = (vA || vB) ? sx : -3.0e38f;
            SC_(sx);
            sv[i] = sx; tmax = fmaxf(tmax, sx); }
    }
    s16x4 t0, t1, t2, t3, t4, t5, t6, t7;
    asm volatile("s_waitcnt lgkmcnt(0)\n\t"
                 "ds_read_b64_tr_b16 %0, %8\n\tds_read_b64_tr_b16 %1, %8 offset:1024\n\tds_read_b64_tr_b16 %2, %8 offset:2048\n\tds_read_b64_tr_b16 %3, %8 offset:3072\n\t"
                 "ds_read_b64_tr_b16 %4, %9\n\tds_read_b64_tr_b16 %5, %9 offset:1024\n\tds_read_b64_tr_b16 %6, %9 offset:2048\n\tds_read_b64_tr_b16 %7, %9 offset:3072"
                 : "=&v"(t0), "=&v"(t1), "=&v"(t2), "=&v"(t3), "=&v"(t4), "=&v"(t5), "=&v"(t6), "=&v"(t7) : "v"(ta0), "v"(ta1) : "memory");
    if (__builtin_amdgcn_ballot_w64(tmax > st.mrun + 8.f) != 0ull) {
        tmax = fmaxf(tmax, __shfl_xor(tmax, 32));
        const float mnew = fmaxf(st.mrun, tmax), alpha = __builtin_amdgcn_exp2f(st.mrun - mnew); st.mrun = mnew;
        st.lrun *= alpha;
#pragma unroll
        for (int i = 0; i < 16; ++i) { float a0 = st.o0[i] * alpha, a1 = st.o1[i] * alpha; SC_(a0); SC_(a1); st.o0[i] = a0; st.o1[i] = a1; }
    }
    const float mn = st.mrun;
    float psum = 0.f;
#pragma unroll
    for (int i = 0; i < 16; ++i) { float e = sv[i] - mn; SC_(e); float pv = __builtin_amdgcn_exp2f(e); SC_(pv); S[i] = pv; psum += pv; }
    st.lrun += psum;
#undef SC_
    bf16x8 pf[2];
#pragma unroll
    for (int s = 0; s < 2; ++s) { u32x4 w; w.x = pk2(S[8 * s], S[8 * s + 1]); w.y = pk2(S[8 * s + 2], S[8 * s + 3]); w.z = pk2(S[8 * s + 4], S[8 * s + 5]); w.w = pk2(S[8 * s + 6], S[8 * s + 7]);
        pf[s] = __builtin_bit_cast(bf16x8, w); }
    asm volatile("s_waitcnt lgkmcnt(0)" : "+v"(t0), "+v"(t1), "+v"(t2), "+v"(t3), "+v"(t4), "+v"(t5), "+v"(t6), "+v"(t7) :: "memory");
    const bf16x8 v00 = __builtin_shufflevector(t0, t1, 0, 1, 2, 3, 4, 5, 6, 7), v01 = __builtin_shufflevector(t2, t3, 0, 1, 2, 3, 4, 5, 6, 7);
    const bf16x8 v10 = __builtin_shufflevector(t4, t5, 0, 1, 2, 3, 4, 5, 6, 7), v11 = __builtin_shufflevector(t6, t7, 0, 1, 2, 3, 4, 5, 6, 7);
    st.o0 = __builtin_amdgcn_mfma_f32_32x32x16_bf16(v00, pf[0], st.o0, 0, 0, 0);
    st.o0 = __builtin_amdgcn_mfma_f32_32x32x16_bf16(v01, pf[1], st.o0, 0, 0, 0);
    st.o1 = __builtin_amdgcn_mfma_f32_32x32x16_bf16(v10, pf[0], st.o1, 0, 0, 0);
    st.o1 = __builtin_amdgcn_mfma_f32_32x32x16_bf16(v11, pf[1], st.o1, 0, 0, 0);
}

DI void attn_item(const bf16_t* __restrict__ proj, bf16_t* __restrict__ mixed, const float* __restrict__ og, unsigned vlds, LAS unsigned char* vptr, int b, int h, int p0,
                  int nb, int nh, int np0, KV& ta, bf16x8 (&qf)[4], int lane) {
    const int r = lane & 31, hh = lane >> 5;
    const bf16_t* base = proj + (size_t)b * SEQ * DIN; const bf16_t* nbase = proj + (size_t)nb * SEQ * DIN;
    const int qpos = p0 + 4 * r;
    AttnState st; st.mrun = -1e30f; st.lrun = 0.f;
#pragma unroll
    for (int i = 0; i < 16; ++i) { st.o0[i] = 0.f; st.o1[i] = 0.f; }
    const float slope2 = __builtin_amdgcn_exp2f(-(float)(h + 1)) * 1.44269504089f;
    const float sc = 0.125f * 1.44269504089f;
    const int i16 = lane & 15, tq = i16 >> 2, tp = i16 & 3, gsub = (lane >> 4) & 1;
    const unsigned ta0 = vlds + (unsigned)((4 * hh + tq) * 128 + ((32 * gsub + 8 * tp) ^ (64 * ((tq >> 1) & 1))));
    const unsigned ta1 = ta0 ^ 64u;
    const int vrow0 = lane >> 3, vch = lane & 7;
    KV tb;
    int cur = next_tile(-1, p0);
    bool in_tb;
    for (;;) {
        int nxt = next_tile(cur, p0);
        load_kv(tb, base, h, nxt, p0, nbase, nh, np0, vrow0, vch);
        attn_tile(st, ta, qf, cur, p0, qpos, r, hh, vrow0, vch, vptr, ta0, ta1, slope2, sc);
        if (nxt >= NT) { in_tb = true; break; }
        cur = nxt; nxt = next_tile(cur, p0);
        load_kv(ta, base, h, nxt, p0, nbase, nh, np0, vrow0, vch);
        attn_tile(st, tb, qf, cur, p0, qpos, r, hh, vrow0, vch, vptr, ta0, ta1, slope2, sc);
        if (nxt >= NT) { in_tb = false; break; }
        cur = nxt;
    }
    { const int nq = np0 + 4 * r;
#pragma unroll
      for (int c = 0; c < 4; ++c) qf[c] = *(const bf16x8*)(nbase + (size_t)nq * DIN + nh * 64 + 16 * c + 8 * hh); }
    float lrun = st.lrun + __shfl_xor(st.lrun, 32);
    const float inv = 1.f / lrun;
    float ssq = 0.f;
#pragma unroll
    for (int i = 0; i < 16; ++i) { st.o0[i] *= inv; st.o1[i] *= inv; ssq += st.o0[i] * st.o0[i] + st.o1[i] * st.o1[i]; }
    ssq += __shfl_xor(ssq, 32);
    const float rstd = rsqrtf(ssq * (1.f / 64.f) + EPS);
    bf16_t* orow = mixed + ((size_t)b * SEQ + qpos) * DM + h * 64;
#pragma unroll
    for (int gi = 0; gi < 4; ++gi) { const int d0 = 8 * gi + 4 * hh;
        const f32x4 g0 = *(const f32x4*)(og + h * 64 + d0), g1 = *(const f32x4*)(og + h * 64 + 32 + d0);
        u32x2 w0, w1;
        w0.x = pk2(st.o0[4 * gi] * rstd * g0[0], st.o0[4 * gi + 1] * rstd * g0[1]); w0.y = pk2(st.o0[4 * gi + 2] * rstd * g0[2], st.o0[4 * gi + 3] * rstd * g0[3]);
        w1.x = pk2(st.o1[4 * gi] * rstd * g1[0], st.o1[4 * gi + 1] * rstd * g1[1]); w1.y = pk2(st.o1[4 * gi + 2] * rstd * g1[2], st.o1[4 * gi + 3] * rstd * g1[3]);
        *(u32x2*)(orow + d0) = w0; *(u32x2*)(orow + 32 + d0) = w1; }
    if (in_tb) ta = tb;
}

DI void unpack8(const u32x4 v, float (&f)[8]) { f[0] = bf_lo(v.x); f[1] = bf_hi(v.x); f[2] = bf_lo(v.y); f[3] = bf_hi(v.y); f[4] = bf_lo(v.z); f[5] = bf_hi(v.z); f[6] = bf_lo(v.w); f[7] = bf_hi(v.w); }

DI void phase_mixer(PP p, int layer, LAS unsigned char* lds, const int tid) {
    const int lane = tid & 63, wave = __builtin_amdgcn_readfirstlane(tid >> 6);
    const bf16_t* proj = (const bf16_t*)(p->ws + WS_PROJ); bf16_t* mixed = (bf16_t*)(p->ws + WS_MIX);
    const int G = gridDim.x, bid = blockIdx.x;
    const int vB = (G % 8 == 0) ? ((bid % 8) * (G / 8) + bid / 8) : bid;
    {
        const float* cw = p->mix_conv_w + (size_t)layer * 3 * 512; const float* cg_ = p->conv_out_g + (size_t)layer * 512;
        const int ch0 = 8 * lane; const int NW = G * 8, gw = vB * 8 + wave; const int per = T / NW;
        float w0[8], w1[8], w2[8], gg[8];
#pragma unroll
        for (int i = 0; i < 8; ++i) { w0[i] = cw[ch0 + i]; w1[i] = cw[512 + ch0 + i]; w2[i] = cw[1024 + ch0 + i]; gg[i] = cg_[ch0 + i]; }
        const int t0 = gw * per;
        float p1[8], p2[8];
#pragma unroll
        for (int i = 0; i < 8; ++i) { p1[i] = 0.f; p2[i] = 0.f; }
        if ((t0 % SEQ) != 0) {
            float a[8], c[8];
            unpack8(*(const u32x4*)(proj + (size_t)(t0 - 2) * DIN + 2048 + ch0), a); unpack8(*(const u32x4*)(proj + (size_t)(t0 - 2) * DIN + 2560 + ch0), c);
#pragma unroll
            for (int i = 0; i < 8; ++i) p2[i] = a[i] * c[i];
            unpack8(*(const u32x4*)(proj + (size_t)(t0 - 1) * DIN + 2048 + ch0), a); unpack8(*(const u32x4*)(proj + (size_t)(t0 - 1) * DIN + 2560 + ch0), c);
#pragma unroll
            for (int i = 0; i < 8; ++i) p1[i] = a[i] * c[i];
        }
        for (int t = t0; t < t0 + per; t += 4) {
            u32x4 rb[4], ra[4], rc[4];
#pragma unroll
            for (int q = 0; q < 4; ++q) { const bf16_t* pr = proj + (size_t)(t + q) * DIN + ch0; rb[q] = *(const u32x4*)(pr + 1536); ra[q] = *(const u32x4*)(pr + 2048); rc[q] = *(const u32x4*)(pr + 2560); }
#pragma unroll
            for (int q = 0; q < 4; ++q) {
                float gb[8], a[8], c[8], y[8];
                unpack8(rb[q], gb); unpack8(ra[q], a); unpack8(rc[q], c);
                float sq = 0.f;
#pragma unroll
                for (int i = 0; i < 8; ++i) { const float cu = a[i] * c[i]; y[i] = gb[i] * (w0[i] * p2[i] + w1[i] * p1[i] + w2[i] * cu); p2[i] = p1[i]; p1[i] = cu; sq += y[i] * y[i]; }
                sq += __shfl_xor(sq, 1); sq += __shfl_xor(sq, 2); sq += __shfl_xor(sq, 4);
                const float rs = rsqrtf(sq * (1.f / 64.f) + EPS);
                u32x4 o; o.x = pk2(y[0] * rs * gg[0], y[1] * rs * gg[1]); o.y = pk2(y[2] * rs * gg[2], y[3] * rs * gg[3]); o.z = pk2(y[4] * rs * gg[4], y[5] * rs * gg[5]); o.w = pk2(y[6] * rs * gg[6], y[7] * rs * gg[7]);
                *(u32x4*)(mixed + (size_t)(t + q) * DM + 512 + ch0) = o;
            }
        }
    }
    {
        const float* og = p->attn_out_g + (size_t)layer * 512;
        LAS unsigned char* vptr = lds + wave * 8192; const unsigned vlds = (unsigned)(size_t)vptr;
        if (G == 256) {
            const int xcd = vB / 32, wl = (vB % 32) * 8 + wave;
            LAS float* scr = (LAS float*)(lds + 65536 + wave * 8448); const int gw = bid * 8 + wave; int wit = I_IN + gw;
            KV ta; bf16x8 qf[4];
            { const int bh = xcd * 16 + wl / 64, c = wl % 64, p0 = 128 * (c >> 2) + (c & 3);
              const bf16_t* base = proj + (size_t)(bh >> 3) * SEQ * DIN; const int r = lane & 31, hh = lane >> 5;
#pragma unroll
              for (int cc = 0; cc < 4; ++cc) qf[cc] = *(const bf16x8*)(base + (size_t)(p0 + 4 * r) * DIN + (bh & 7) * 64 + 16 * cc + 8 * hh);
              int kb, ks, W, cls; tile_desc(next_tile(-1, p0), p0, kb, ks, W, cls); load_kv_at(ta, base, bh & 7, kb, ks, lane >> 3, lane & 7); }
            for (int k = 0; k < 4; ++k) {
                const int bh = xcd * 16 + k * 4 + wl / 64, c = (wl % 64 + 16 * k) % 64;
                const int kn = k < 3 ? k + 1 : k, nbh = xcd * 16 + kn * 4 + wl / 64, nc = (wl % 64 + 16 * kn) % 64;
                attn_item(proj, mixed, og, vlds, vptr, bh >> 3, bh & 7, 128 * (c >> 2) + (c & 3), nbh >> 3, nbh & 7, 128 * (nc >> 2) + (nc & 3), ta, qf, lane);
                if (layer == 0 && wit < NL * I_L) { weight_item2(p, wit, wit + G * 8, wit + G * 8 < NL * I_L, scr, lane); wit += 2 * G * 8; }
            }
        }
    }
}

DI void fixup_tile(PP p, int layer, const int tid, const int pm) {
    if ((pm & 7) == 0) return;
    const float* H = (const float*)(p->ws + WS_H); bf16_t* act = (bf16_t*)(p->ws + WS_PROJ); const float* cw = p->ffn_conv_w + (size_t)layer * 3 * DUP;
    const float* Hc = H + (size_t)pm * 4 * DUP; const float* Hp = H + (size_t)(pm - 1) * 4 * DUP;
    for (int idx = tid; idx < 2 * DFF; idx += 512) {
        const int i = idx / DFF, c = idx % DFF;
        const int gcol = (c >> 7) * 256 + (c & 127), vcol = gcol + 128;
        float g0, g1, g2, v0, v1, v2;
        if (i == 0) { g0 = Hc[gcol]; g1 = Hp[3 * DUP + gcol]; g2 = Hp[2 * DUP + gcol]; v0 = Hc[vcol]; v1 = Hp[3 * DUP + vcol]; v2 = Hp[2 * DUP + vcol]; }
        else { g0 = Hc[DUP + gcol]; g1 = Hc[gcol]; g2 = Hp[3 * DUP + gcol]; v0 = Hc[DUP + vcol]; v1 = Hc[vcol]; v2 = Hp[3 * DUP + vcol]; }
        const float yg = cw[2 * DUP + c] * g0 + cw[DUP + c] * g1 + cw[c] * g2;
        const float yv = cw[2 * DUP + DFF + c] * v0 + cw[DUP + DFF + c] * v1 + cw[DFF + c] * v2;
        const float a = silu_mul(yg, yv);
        const unsigned pk = pk2(a, a);
        act[(size_t)(pm * 256 + i) * DFF + c] = (bf16_t)(pk & 0xffffu);
    }
}

DI void phase_final(PP p, const int tid) {
    const int lane = tid & 63, wave = tid >> 6; const float* ss = (const float*)(p->ws + WS_SS); const bf16_t* xb = (const bf16_t*)(p->ws + WS_XB);
    f32x4 g[4];
#pragma unroll
    for (int j = 0; j < 2; ++j) { g[2 * j] = *(const f32x4*)(p->final_norm_g + 8 * lane + 512 * j); g[2 * j + 1] = *(const f32x4*)(p->final_norm_g + 8 * lane + 512 * j + 4); }
    for (int row0 = (blockIdx.x * 8 + wave) * 4; row0 < T; row0 += gridDim.x * 8 * 4) {
        u32x4 xv[4][2]; float sr[4];
#pragma unroll
        for (int q = 0; q < 4; ++q) {
#pragma unroll
            for (int j = 0; j < 2; ++j) xv[q][j] = *(const u32x4*)(xb + (size_t)(row0 + q) * DM + 8 * lane + 512 * j);
            float s = 0.f;
#pragma unroll
            for (int pl = 0; pl < 16; ++pl) s += ss[(size_t)pl * T + row0 + q];
            sr[q] = rsqrtf(s * (1.f / DM) + EPS);
        }
#pragma unroll
        for (int q = 0; q < 4; ++q)
#pragma unroll
            for (int j = 0; j < 2; ++j) { const size_t o = (size_t)(row0 + q) * DM + 8 * lane + 512 * j; const u32x4 x4 = xv[q][j]; const float rs = sr[q];
                f32x4 v0 = {bf_lo(x4.x), bf_hi(x4.x), bf_lo(x4.y), bf_hi(x4.y)}, v1 = {bf_lo(x4.z), bf_hi(x4.z), bf_lo(x4.w), bf_hi(x4.w)};
                *(f32x4*)(p->out + o) = v0 * rs * g[2 * j]; *(f32x4*)(p->out + o + 4) = v1 * rs * g[2 * j + 1]; }
    }
}

#define XB_TMO      128
#define XB_XCNT(j)  (256  + 64 * (j))
#define XB_XSUB(j)  (1280 + 64 * (j))
#define XB_XGEN(j)  (2304 + 64 * (j))
#define XB_TOP      3328
#define XB_TOPGEN   3392
#define XCD_BAR_WORDS 3456
#define XB_SPIN_CAP (1u << 18)
DI unsigned xb_ld(unsigned* p)              { return __hip_atomic_load(p, __ATOMIC_RELAXED, __HIP_MEMORY_SCOPE_AGENT); }
DI unsigned xb_add(unsigned* p, unsigned v) { return __hip_atomic_fetch_add(p, v, __ATOMIC_RELAXED, __HIP_MEMORY_SCOPE_AGENT); }
DI unsigned xb_xcc_id() { return (unsigned)__builtin_amdgcn_s_getreg((3 << 11) | 20) & 0xFu; }
#define XB_SPIN(cond, bar) do { unsigned _sp = 0; while (cond) { __builtin_amdgcn_s_sleep(1); \
    if ((++_sp & 255u) == 0u) { if (xb_ld(&(bar)[XB_TMO])) break; if (_sp > XB_SPIN_CAP) { atomicAdd(&(bar)[XB_TMO], 1u); break; } } } } while (0)
struct XcdBarrier { unsigned* bar; unsigned x; volatile LAS unsigned* st; };
DI XcdBarrier xcd_barrier_post(unsigned* bar, volatile LAS unsigned* st) {
    XcdBarrier b; b.bar = bar; b.x = xb_xcc_id(); b.st = st;
    if (threadIdx.x == 0) (void)xb_add(&bar[XB_XCNT(b.x)], 1u);
    return b;
}
DI void xcd_barrier_complete(unsigned* bar, unsigned x, unsigned& nloc, unsigned& nx) {
    const unsigned G = gridDim.x * gridDim.y * gridDim.z;
    unsigned sum, cnt, mine, sp = 0u;
    for (;;) {
        sum = 0u; cnt = 0u; mine = 0u;
#pragma unroll
        for (unsigned j = 0; j < 16; ++j) { const unsigned c = xb_ld(&bar[XB_XCNT(j)]); sum += c; cnt += (c > 0u) ? 1u : 0u; mine = (j == x) ? c : mine; }
        if (sum == G) break;
        __builtin_amdgcn_s_sleep(1);
        if ((++sp & 255u) == 0u) { if (xb_ld(&bar[XB_TMO])) break; if (sp > XB_SPIN_CAP) { atomicAdd(&bar[XB_TMO], 1u); break; } }
    }
    nloc = mine > 0u ? mine : 1u; nx = cnt > 0u ? cnt : 1u;
}
DI void xcd_barrier(const XcdBarrier& b, const int tid) {
    asm volatile("s_waitcnt vmcnt(0)" ::: "memory");
    __syncthreads();
    if (tid == 0) {
        unsigned* bar = b.bar; asm volatile("" : "+s"(bar));
        __builtin_amdgcn_s_waitcnt(0);
        unsigned nloc = b.st[0], nx = b.st[1];
        if (nloc == 0u) { xcd_barrier_complete(bar, b.x, nloc, nx); b.st[0] = nloc; b.st[1] = nx; }
        const unsigned old = xb_add(&bar[XB_XSUB(b.x)], 1u);
        const unsigned gen = old / nloc;
        if (old + 1u == (gen + 1u) * nloc) {
            __builtin_amdgcn_fence(__ATOMIC_RELEASE, "agent");
            asm volatile("s_waitcnt vmcnt(0)" ::: "memory");
            const unsigned og = xb_add(&bar[XB_TOP], 1u);
            const unsigned tg = og / nx;
            if (og + 1u == (tg + 1u) * nx) xb_add(&bar[XB_TOPGEN], 1u);
            else XB_SPIN(xb_ld(&bar[XB_TOPGEN]) == tg, bar);
            __builtin_amdgcn_fence(__ATOMIC_ACQUIRE, "agent");
            xb_add(&bar[XB_XGEN(b.x)], 1u);
            asm volatile("s_waitcnt vmcnt(0)" ::: "memory");
        } else {
            XB_SPIN(xb_ld(&bar[XB_XGEN(b.x)]) == gen, bar);
            __builtin_amdgcn_fence(__ATOMIC_ACQUIRE, "agent");
            asm volatile("s_waitcnt vmcnt(0)" ::: "memory");
        }
    }
    __syncthreads();
}

__global__ __launch_bounds__(512, 2) void fwd_kernel(Params parg) {
    extern __shared__ __attribute__((aligned(16))) unsigned char shm[];
    LAS unsigned char* lds = (LAS unsigned char*)shm;
    const int ph_lo = parg.ph_lo, ph_hi = parg.ph_hi, coop = parg.coop;
    const int wave_id = __builtin_amdgcn_readfirstlane((int)(threadIdx.x >> 6));
    volatile LAS unsigned* xst = (volatile LAS unsigned*)(lds + XB_ST_OFF);
    if (threadIdx.x == 0) { xst[0] = 0u; xst[1] = 0u; xst[2] = 0u; xst[3] = 0u; }
    __syncthreads();
    XcdBarrier xb_; xb_.bar = (unsigned*)(parg.ws + WS_BAR); xb_.x = 0; xb_.st = xst;
    if (coop == 1) xb_ = xcd_barrier_post((unsigned*)(parg.ws + WS_BAR), xst);
#ifdef PROBE_REP
    for (int ph2 = ph_lo; ph2 < ph_hi + 1; ++ph2) {
        const int ph = ph2 <= PROBE_REP ? ph2 : ph2 - 1;
#else
    for (int ph = ph_lo; ph < ph_hi; ++ph) {
#endif
        int wv_ = wave_id; asm volatile("" : "+s"(wv_));
        int tid = wv_ * 64 + (int)__builtin_amdgcn_mbcnt_hi(~0u, __builtin_amdgcn_mbcnt_lo(~0u, 0u)); asm volatile("" : "+v"(tid));
        PP p = (PP)__builtin_amdgcn_kernarg_segment_ptr(); asm volatile("" : "+s"(p));
        unsigned char* ws = p->ws;
        bf16_t* xb = (bf16_t*)(ws + WS_XB); float* ss = (float*)(ws + WS_SS);
        StaticOrder S;
        if (ph == 0) phase_prep(p, lds, tid);
        else if (ph == NPHASE - 1) phase_final(p, tid);
        else {
            const int layer = (ph - 1) / 5, sub = (ph - 1) % 5;
            if (sub == 0) {
                Gemm g; g.A = xb; g.Bt = (const bf16_t*)(ws + WS_WIN + layer * SZ_WIN); g.M = T; g.N = DIN; g.K = DM;
                EpiProj E; E.O = (bf16_t*)(ws + WS_PROJ); E.ss = ss;
                S.init(g.M, g.N, (int)gridDim.x, (int)blockIdx.x);
                rstd_table(lds, S, ss, tid);
                gemm_phase<EpiProj>(lds, g, S, E, tid);
            } else if (sub == 1) {
                phase_mixer(p, layer, lds, tid);
            } else if (sub == 2 || sub == 4) {
                Gemm g; g.M = T; g.N = DM;
                if (sub == 2) { g.A = (const bf16_t*)(ws + WS_MIX); g.Bt = (const bf16_t*)(ws + WS_WOUT + layer * SZ_WOUT); g.K = DM; }
                else { g.A = (const bf16_t*)(ws + WS_PROJ); g.Bt = (const bf16_t*)(ws + WS_WDN + layer * SZ_WDN); g.K = DFF; }
                EpiRes E; E.xb = xb; E.ss = ss;
                S.init(g.M, g.N, (int)gridDim.x, (int)blockIdx.x);
                if (sub == 4) {
                    Unit u; for (int i = 0; S.next(i, u); ++i) fixup_tile(p, layer, tid, u.pm);
                    asm volatile("s_waitcnt vmcnt(0)" ::: "memory"); __syncthreads();
                }
                gemm_phase<EpiRes>(lds, g, S, E, tid);
            } else {
                Gemm g; g.A = xb; g.Bt = (const bf16_t*)(ws + WS_WUP + layer * SZ_WUP); g.M = T; g.N = DUP; g.K = DM;
                EpiUp E; E.act = (bf16_t*)(ws + WS_PROJ); E.ss = ss; E.cw = p->ffn_conv_w + (size_t)layer * 3 * DUP; E.H = (float*)(ws + WS_H);
                S.init(g.M, g.N, (int)gridDim.x, (int)blockIdx.x);
                gemm_phase<EpiUp>(lds, g, S, E, tid);
            }
        }
#ifdef PROBE_REP
        if (ph2 < ph_hi) { if (coop == 1) xcd_barrier(xb_, tid); else if (coop == 2) cg::this_grid().sync(); }
#else
        if (ph + 1 < ph_hi) { if (coop == 1) xcd_barrier(xb_, tid); else if (coop == 2) cg::this_grid().sync(); }
#endif
    }
}

extern "C" void kernel_launch(void* const* d_in, const int* in_sizes, int n_in, void* d_out, int out_size, void* d_ws, size_t ws_size, hipStream_t stream) {
    static int grid = 0;
    if (grid == 0) {
        if (n_in != 12 || out_size != T * DM || ws_size < WS_END) { fprintf(stderr, "kernel_launch: unexpected shapes (n_in %d out %d ws %zu need %zu)\n", n_in, out_size, ws_size, (size_t)WS_END); grid = -1; return; }
        int dev = 0, cus = 0, per_cu = 0;
        (void)hipGetDevice(&dev); (void)hipDeviceGetAttribute(&cus, hipDeviceAttributeMultiprocessorCount, dev);
        if (hipFuncSetAttribute((const void*)fwd_kernel, hipFuncAttributeMaxDynamicSharedMemorySize, LDS_BYTES) != hipSuccess) { fprintf(stderr, "hipFuncSetAttribute failed\n"); grid = -1; return; }
        (void)hipOccupancyMaxActiveBlocksPerMultiprocessor(&per_cu, (const void*)fwd_kernel, 512, LDS_BYTES);
        if (per_cu < 1) per_cu = 1;
        (void)hipGetLastError();
        grid = cus;
    }
    if (grid < 0) return;
    Params p{};
    p.x = (const float*)d_in[0]; p.norm1_g = (const float*)d_in[1]; p.w_in = (const float*)d_in[2]; p.mix_conv_w = (const float*)d_in[3];
    p.attn_out_g = (const float*)d_in[4]; p.conv_out_g = (const float*)d_in[5]; p.w_out = (const float*)d_in[6]; p.norm2_g = (const float*)d_in[7];
    p.ffn_up = (const float*)d_in[8]; p.ffn_conv_w = (const float*)d_in[9]; p.ffn_down = (const float*)d_in[10]; p.final_norm_g = (const float*)d_in[11];
    p.out = (float*)d_out; p.ws = (unsigned char*)d_ws; p.pad = 0;
#if defined(MULTI_LAUNCH)
    for (int ph = 0; ph < NPHASE; ++ph) { p.ph_lo = ph; p.ph_hi = ph + 1; p.coop = 0;
        hipLaunchKernelGGL(fwd_kernel, dim3(grid), dim3(512), LDS_BYTES, stream, p); }
#else
    p.ph_lo = 0; p.ph_hi = NPHASE; p.coop = 1;
    if (hipMemsetAsync((char*)d_ws + WS_BAR, 0, 16384, stream) != hipSuccess) { fprintf(stderr, "memset of barrier words failed\n"); return; }
    void* args[] = {&p};
    hipError_t e = hipLaunchCooperativeKernel((const void*)fwd_kernel, dim3(grid), dim3(512), args, LDS_BYTES, stream);
    if (e != hipSuccess) fprintf(stderr, "cooperative launch failed: %s (grid %d)\n", hipGetErrorString(e), grid);
#endif
}
```

```cpp
#include <hip/hip_runtime.h>
#include <hip/hip_cooperative_groups.h>
#include <cstdio>
namespace cg = cooperative_groups;

#define LAS __attribute__((address_space(3)))
#define DI __device__ __forceinline__
typedef unsigned short bf16_t;
typedef short bf16x8 __attribute__((ext_vector_type(8)));
typedef short s16x4 __attribute__((ext_vector_type(4)));
typedef float f32x2 __attribute__((ext_vector_type(2)));
typedef float f32x4 __attribute__((ext_vector_type(4)));
typedef float f32x16 __attribute__((ext_vector_type(16)));
typedef unsigned u32x2 __attribute__((ext_vector_type(2)));
typedef unsigned u32x4 __attribute__((ext_vector_type(4)));
typedef __bf16 bf16v2 __attribute__((ext_vector_type(2)));

constexpr int T = 32768, SEQ = 2048, DM = 1024, DIN = 3072, DFF = 2816, DUP = 5632, NL = 2;
constexpr float EPS = 1e-6f;
constexpr int BM = 256, BK = 64, HALF = 128, HTB = HALF * BK * 2, STAGE_BYTES = 8 * HTB, NXCD = 8, WGM = 4;
constexpr int XCH_OFF = STAGE_BYTES, XB_ST_OFF = STAGE_BYTES + 2048, RST_OFF = STAGE_BYTES + 4096, LDS_BYTES = STAGE_BYTES + 4096 + 12 * 1024;
constexpr int NPHASE = 12;

constexpr size_t SZ_WIN = (size_t)DIN * DM * 2, SZ_WOUT = (size_t)DM * DM * 2, SZ_WUP = (size_t)DUP * DM * 2, SZ_WDN = (size_t)DM * DFF * 2;
constexpr size_t WS_WIN = 0, WS_WOUT = WS_WIN + NL * SZ_WIN, WS_WUP = WS_WOUT + NL * SZ_WOUT, WS_WDN = WS_WUP + NL * SZ_WUP;
constexpr size_t WS_XB = WS_WDN + NL * SZ_WDN;
constexpr size_t WS_PROJ = WS_XB + (size_t)T * DM * 2;
constexpr size_t WS_MIX = WS_PROJ + (size_t)T * DIN * 2;
constexpr size_t WS_SS = WS_MIX + (size_t)T * DM * 2;
constexpr size_t WS_H = WS_SS + (size_t)16 * T * 4;
constexpr size_t WS_BAR = WS_H + (size_t)128 * 4 * DUP * 4;
constexpr size_t WS_END = WS_BAR + 16384;

struct Params;
typedef const __attribute__((address_space(4))) Params* PP;
struct Params {
    const float* x; const float* norm1_g; const float* w_in; const float* mix_conv_w; const float* attn_out_g; const float* conv_out_g;
    const float* w_out; const float* norm2_g; const float* ffn_up; const float* ffn_conv_w; const float* ffn_down; const float* final_norm_g;
    float* out; unsigned char* ws; int ph_lo, ph_hi, coop, pad;
};

DI unsigned pk2(float a, float b) { f32x2 v = {a, b}; bf16v2 r = __builtin_convertvector(v, bf16v2); return __builtin_bit_cast(unsigned, r); }
DI float bf_lo(unsigned u) { return __uint_as_float(u << 16); }
DI float bf_hi(unsigned u) { return __uint_as_float(u & 0xffff0000u); }
DI float xor16_32(float v) { v += __shfl_xor(v, 16); v += __shfl_xor(v, 32); return v; }

__host__ __device__ __forceinline__ int lds_byte(int r, int c) { const int st = (r >> 4) * 2 + (c >> 5), rr = r & 15, cc = c & 31, ob = rr * 64 + cc * 2; return st * 1024 + (ob ^ (((ob >> 9) & 1) << 5)); }
__host__ __device__ __forceinline__ void stage_rc(int b, int& R, int& C) { const int st = b / 1024, sb = b % 1024, swz = sb ^ (((sb >> 9) & 1) << 5); R = (st >> 1) * 16 + swz / 64; C = (st & 1) * 32 + (swz % 64) / 2; }
__host__ __device__ __forceinline__ int perm32(int rho) { const int n = rho >> 4, i = rho & 15; return 8 * (i >> 2) + 4 * n + (i & 3); }

struct Unit { int pm, pn; };
struct Gemm { const bf16_t* A; const bf16_t* Bt; int M, N, K; };
struct StaticOrder {
    int nM, nN, nwg, G, c;
    DI void init(int M, int N, int G_, int c_) { nM = M / BM; nN = N / BM; nwg = nM * nN; G = G_; c = c_; }
    DI bool next(int i, Unit& u) const {
        const long L = (long)i * G + c; if (L >= nwg) return false;
        int wgid = (int)L; { const int q = nwg / NXCD, r = nwg % NXCD, xcd = wgid % NXCD, off = wgid / NXCD; wgid = (xcd < r ? xcd * (q + 1) : r * (q + 1) + (xcd - r) * q) + off; }
        const int nig = WGM * nN, gid = wgid / nig, fm = gid * WGM, gsz = (nM - fm) < WGM ? (nM - fm) : WGM;
        u.pm = fm + ((wgid % nig) % gsz); u.pn = (wgid % nig) / gsz; return true;
    }
};


DI float row_rstd(const float* ss, int row, int fq) {
    const float* p = ss + (size_t)(4 * fq) * T + row;
    float s = (p[0] + p[T]) + (p[2 * T] + p[3 * T]);
    s = xor16_32(s);
    return rsqrtf(s * (1.f / DM) + EPS);
}

struct EpiProj {
    static constexpr bool PERM = true, ROWPERM = false;
    bf16_t* O; const float* ss;
    DI void operator()(f32x4 (&acc)[2][2][4][2], const Unit& u, int wr, int wc, int fr, int fq, LAS unsigned char* lds, int ui) const {
        const int row0 = u.pm * BM + wr * 64 + fr, col0 = u.pn * BM + wc * 32 + 8 * fq;
#pragma unroll
        for (int ai = 0; ai < 2; ++ai)
#pragma unroll
            for (int m = 0; m < 4; ++m) {
                const int row = row0 + ai * HALF + m * 16; const float rs = ((const LAS float*)(lds + RST_OFF))[ui * 256 + ai * HALF + wr * 64 + m * 16 + fr];
                bf16_t* rowp = O + (size_t)row * DIN + col0;
#pragma unroll
                for (int bj = 0; bj < 2; ++bj) { const f32x4 v0 = acc[ai][bj][m][0] * rs, v1 = acc[ai][bj][m][1] * rs;
                    u32x4 w; w.x = pk2(v0[0], v0[1]); w.y = pk2(v0[2], v0[3]); w.z = pk2(v1[0], v1[1]); w.w = pk2(v1[2], v1[3]);
                    *(u32x4*)(rowp + bj * HALF) = w; }
                asm volatile("" ::: "memory");
            }
    }
};

struct EpiRes {
    static constexpr bool PERM = true, ROWPERM = false;
    bf16_t* xb; float* ss;
    DI void operator()(f32x4 (&acc)[2][2][4][2], const Unit& u, int wr, int wc, int fr, int fq, LAS unsigned char* lds, int ui) const {
        const int row0 = u.pm * BM + wr * 64 + fr, col0 = u.pn * BM + wc * 32 + 8 * fq;
#pragma unroll
        for (int ai = 0; ai < 2; ++ai) {
            u32x4 xv[4][2];
#pragma unroll
            for (int m = 0; m < 4; ++m)
#pragma unroll
                for (int bj = 0; bj < 2; ++bj) xv[m][bj] = *(const u32x4*)(xb + (size_t)(row0 + ai * HALF + m * 16) * DM + col0 + bj * HALF);
            float sq[4];
#pragma unroll
            for (int m = 0; m < 4; ++m) {
                bf16_t* rowp = xb + (size_t)(row0 + ai * HALF + m * 16) * DM + col0; float q = 0.f;
#pragma unroll
                for (int bj = 0; bj < 2; ++bj) {
                    const u32x4 x4 = xv[m][bj];
                    const f32x4 a0 = acc[ai][bj][m][0], a1 = acc[ai][bj][m][1];
                    u32x4 w; w.x = pk2(bf_lo(x4.x) + a0[0], bf_hi(x4.x) + a0[1]); w.y = pk2(bf_lo(x4.y) + a0[2], bf_hi(x4.y) + a0[3]);
                    w.z = pk2(bf_lo(x4.z) + a1[0], bf_hi(x4.z) + a1[1]); w.w = pk2(bf_lo(x4.w) + a1[2], bf_hi(x4.w) + a1[3]);
                    *(u32x4*)(rowp + bj * HALF) = w;
                    q += (bf_lo(w.x) * bf_lo(w.x) + bf_hi(w.x) * bf_hi(w.x)) + (bf_lo(w.y) * bf_lo(w.y) + bf_hi(w.y) * bf_hi(w.y))
                       + (bf_lo(w.z) * bf_lo(w.z) + bf_hi(w.z) * bf_hi(w.z)) + (bf_lo(w.w) * bf_lo(w.w) + bf_hi(w.w) * bf_hi(w.w));
                }
                sq[m] = q;
            }
#pragma unroll
            for (int m = 0; m < 4; ++m) { const float q = xor16_32(sq[m]); if (fq == 0) ss[(size_t)(u.pn * 4 + wc) * T + row0 + ai * HALF + m * 16] = q; }
            asm volatile("" ::: "memory");
        }
    }
};

DI float dpp_shr1(float v) { return __int_as_float(__builtin_amdgcn_update_dpp(0, __float_as_int(v), 0x111, 0xf, 0xf, true)); }
DI float silu_mul(float g, float v) { return g * v * __builtin_amdgcn_rcpf(1.f + __builtin_amdgcn_exp2f(-1.44269504089f * g)); }

struct EpiUp {
    static constexpr bool PERM = true, ROWPERM = true;
    bf16_t* act; const float* ss; const float* cw; float* H;
    DI void operator()(f32x4 (&acc)[2][2][4][2], const Unit& u, int wr, int wc, int fr, int fq, LAS unsigned char* lds, int ui) const {
        const int row0 = u.pm * BM + wr * 128 + fr * 8;
        const int ct = wc * 32 + 8 * fq;
        {
            float s8[8];
#pragma unroll
            for (int i = 0; i < 8; ++i) s8[i] = 0.f;
#pragma unroll
            for (int pl = 0; pl < 4; ++pl) { const float* p = ss + (size_t)(4 * fq + pl) * T + row0; const f32x4 a = *(const f32x4*)p, b = *(const f32x4*)(p + 4);
#pragma unroll
                for (int i = 0; i < 4; ++i) { s8[i] += a[i]; s8[4 + i] += b[i]; } }
#pragma unroll
            for (int i = 0; i < 8; ++i) { const float rs = rsqrtf(xor16_32(s8[i]) * (1.f / DM) + EPS);
#pragma unroll
                for (int bj = 0; bj < 2; ++bj)
#pragma unroll
                    for (int n = 0; n < 2; ++n) acc[i >> 2][bj][i & 3][n] *= rs; }
        }
        LAS float* xch = (LAS float*)(lds + XCH_OFF);
        if (fr == 0 && wr == 0) {
#pragma unroll
            for (int k = 0; k < 2; ++k)
#pragma unroll
                for (int bj = 0; bj < 2; ++bj)
#pragma unroll
                    for (int n = 0; n < 2; ++n) *(f32x4*)(H + ((size_t)u.pm * 4 + k) * DUP + u.pn * BM + bj * HALF + ct + 4 * n) = acc[0][bj][k][n];
        }
        if (fr == 15) {
            if (wr == 1) {
#pragma unroll
                for (int k = 0; k < 2; ++k)
#pragma unroll
                    for (int bj = 0; bj < 2; ++bj)
#pragma unroll
                        for (int n = 0; n < 2; ++n) *(f32x4*)(H + ((size_t)u.pm * 4 + 2 + k) * DUP + u.pn * BM + bj * HALF + ct + 4 * n) = acc[1][bj][2 + k][n];
            } else {
#pragma unroll
                for (int k = 0; k < 2; ++k)
#pragma unroll
                    for (int bj = 0; bj < 2; ++bj)
#pragma unroll
                        for (int n = 0; n < 2; ++n) *(LAS f32x4*)(xch + ((wc * 4 + fq) * 2 + k) * 16 + (bj * 2 + n) * 4) = acc[1][bj][2 + k][n];
            }
        }
        asm volatile("s_waitcnt lgkmcnt(0)" ::: "memory");
        __builtin_amdgcn_s_barrier();
        asm volatile("" ::: "memory");
        const size_t cwc = (size_t)u.pn * 128 + ct;
#pragma unroll
        for (int n = 0; n < 2; ++n) {
            f32x4 w[2][3];
#pragma unroll
            for (int bj = 0; bj < 2; ++bj)
#pragma unroll
                for (int k = 0; k < 3; ++k) w[bj][k] = *(const f32x4*)(cw + (size_t)k * DUP + bj * DFF + cwc + 4 * n);
#pragma unroll
            for (int bj = 0; bj < 2; ++bj) {
                f32x4 h1, h2;
#pragma unroll
                for (int e = 0; e < 4; ++e) { h1[e] = dpp_shr1(acc[1][bj][3][n][e]); h2[e] = dpp_shr1(acc[1][bj][2][n][e]); }
                if (fr == 0) {
                    if (wr == 1) { h2 = *(LAS f32x4*)(xch + ((wc * 4 + fq) * 2 + 0) * 16 + (bj * 2 + n) * 4); h1 = *(LAS f32x4*)(xch + ((wc * 4 + fq) * 2 + 1) * 16 + (bj * 2 + n) * 4); }
                    else { h1 = (f32x4){0.f, 0.f, 0.f, 0.f}; h2 = h1; }
                }
#pragma unroll
                for (int i = 7; i >= 0; --i) {
                    const f32x4 p0 = acc[i >> 2][bj][i & 3][n];
                    const f32x4 p1 = (i >= 1) ? acc[(i - 1) >> 2][bj][(i - 1) & 3][n] : h1;
                    const f32x4 p2 = (i >= 2) ? acc[(i - 2) >> 2][bj][(i - 2) & 3][n] : (i == 1 ? h1 : h2);
                    acc[i >> 2][bj][i & 3][n] = w[bj][2] * p0 + w[bj][1] * p1 + w[bj][0] * p2;
                }
            }
#pragma unroll
            for (int i = 0; i < 8; ++i)
#pragma unroll
                for (int e = 0; e < 4; ++e) acc[i >> 2][0][i & 3][n][e] = silu_mul(acc[i >> 2][0][i & 3][n][e], acc[i >> 2][1][i & 3][n][e]);
            asm volatile("" ::: "memory");
        }
#pragma unroll
        for (int i = 0; i < 8; ++i) { const f32x4 v0 = acc[i >> 2][0][i & 3][0], v1 = acc[i >> 2][0][i & 3][1];
            u32x4 o; o.x = pk2(v0[0], v0[1]); o.y = pk2(v0[2], v0[3]); o.z = pk2(v1[0], v1[1]); o.w = pk2(v1[2], v1[3]);
            *(u32x4*)(act + (size_t)(row0 + i) * DFF + cwc) = o; asm volatile("" ::: "memory"); }
    }
};

DI void rstd_table(LAS unsigned char* lds, const StaticOrder& S, const float* __restrict__ ss, const int tid) {
    LAS float* rt = (LAS float*)(lds + RST_OFF);
    const int row = tid & 255, par = tid >> 8;
    Unit u;
    for (int i = par; S.next(i, u); i += 2) {
        const float* p = ss + (size_t)u.pm * BM + row; float s = 0.f;
#pragma unroll
        for (int pl = 0; pl < 16; ++pl) s += p[(size_t)pl * T];
        rt[i * 256 + row] = rsqrtf(s * (1.f / DM) + EPS);
    }
    __syncthreads();
}

template <class Epi>
DI void gemm_phase(LAS unsigned char* lds, const Gemm g, const StaticOrder& S, const Epi& E, const int tid) {
    const int wid = __builtin_amdgcn_readfirstlane(tid >> 6), lane = tid & 63, wr = wid >> 2, wc = wid & 3, fr = lane & 15, fq = lane >> 4;
    const int K = g.K, nt = K / BK;
    unsigned voffA[2], voffB[2];
#pragma unroll
    for (int i = 0; i < 2; ++i) { int R, C; stage_rc(tid * 16 + i * 8192, R, C); const int Rb = Epi::PERM ? ((R & ~31) + perm32(R & 31)) : R;
        voffB[i] = (unsigned)(Rb * K + C) * 2u;
        const int Ra = Epi::ROWPERM ? (128 * (R >> 6) + 8 * (R & 15) + ((R >> 4) & 3)) : R;
        voffA[i] = (unsigned)(Ra * K + C) * 2u; }
    const size_t kstep = (size_t)(BK * 2);
    const size_t hstep = (size_t)HALF * K * 2;
    const size_t tstep = 2 * hstep;
    const size_t astep = Epi::ROWPERM ? (size_t)4 * K * 2 : hstep;
    const unsigned ldsw = (unsigned)wid * 1024u;
    const int aoff = lds_byte(wr * 64 + fr, fq * 8), boff = lds_byte(wc * 32 + fr, fq * 8);
#define PG8_SA(b, h) (((b) * 2 + (h)) * HTB)
#define PG8_SB(b, h) ((4 + (b) * 2 + (h)) * HTB)
#define PG8_STAGE(bufoff, gbase, voff) do { _Pragma("unroll") for (int _i = 0; _i < 2; ++_i) \
        __builtin_amdgcn_global_load_lds((const unsigned*)((const char*)(gbase) + (voff)[_i]), (LAS unsigned*)(lds + (bufoff) + ldsw + _i * 8192), 16, 0, 0); } while (0)
#define PG8_LDA(dst, b, h) do { _Pragma("unroll") for (int m = 0; m < 4; ++m) _Pragma("unroll") for (int k = 0; k < 2; ++k) dst[m][k] = *(const LAS bf16x8*)(lds + PG8_SA(b, h) + aoff + m * 2048 + k * 1024); } while (0)
#define PG8_LDB(dst, b, h) do { _Pragma("unroll") for (int n = 0; n < 2; ++n) _Pragma("unroll") for (int k = 0; k < 2; ++k) dst[n][k] = *(const LAS bf16x8*)(lds + PG8_SB(b, h) + boff + n * 2048 + k * 1024); } while (0)
#define PG8_MMA(ai, bj, At, Bt) do { __builtin_amdgcn_s_setprio(1); _Pragma("unroll") for (int m = 0; m < 4; ++m) _Pragma("unroll") for (int n = 0; n < 2; ++n) _Pragma("unroll") for (int k = 0; k < 2; ++k) \
        acc[ai][bj][m][n] = __builtin_amdgcn_mfma_f32_16x16x32_bf16(Bt[n][k], At[m][k], acc[ai][bj][m][n], 0, 0, 0); __builtin_amdgcn_s_setprio(0); } while (0)
#define PG8_WAIT_V(n) asm volatile("s_waitcnt vmcnt(" #n ")" ::: "memory")
#define PG8_WAIT_L(n) asm volatile("s_waitcnt lgkmcnt(" #n ")" ::: "memory")
#define PG8_BAR __builtin_amdgcn_s_barrier()
#define PG8_SCHED __builtin_amdgcn_sched_barrier(0)
    Unit cur, nxt; int ui = 0;
    if (!S.next(0, cur)) return;
    f32x4 acc[2][2][4][2];
#pragma unroll
    for (int a = 0; a < 2; ++a)
#pragma unroll
        for (int b = 0; b < 2; ++b)
#pragma unroll
            for (int m = 0; m < 4; ++m)
#pragma unroll
                for (int n = 0; n < 2; ++n) acc[a][b][m][n] = (f32x4){0.f, 0.f, 0.f, 0.f};
    bf16x8 At[4][2], B0[2][2], B1[2][2];
    const char* cA = (const char*)g.A + (size_t)cur.pm * tstep; const char* cB = (const char*)g.Bt + (size_t)cur.pn * tstep;
    PG8_STAGE(PG8_SB(0, 0), cB, voffB); PG8_STAGE(PG8_SB(0, 1), cB + hstep, voffB); PG8_STAGE(PG8_SA(0, 0), cA, voffA); PG8_STAGE(PG8_SA(0, 1), cA + astep, voffA);
    if (wr == 1) PG8_BAR;
    PG8_WAIT_V(2); PG8_BAR;
    PG8_STAGE(PG8_SB(1, 0), cB + kstep, voffB); PG8_STAGE(PG8_SA(1, 0), cA + kstep, voffA); PG8_STAGE(PG8_SB(1, 1), cB + hstep + kstep, voffB);
    PG8_WAIT_V(6); PG8_BAR;
    for (;;) {
        const bool has_next = S.next(ui + 1, nxt);
        const char* nA = has_next ? (const char*)g.A + (size_t)nxt.pm * tstep : cA; const char* nB = has_next ? (const char*)g.Bt + (size_t)nxt.pn * tstep : cB;
        for (int t = 0; t < nt; t += 2) {
            const bool last = (t == nt - 2);
            const char* a1 = cA + (size_t)(t + 1) * kstep;
            const char* a2 = last ? nA : cA + (size_t)(t + 2) * kstep; const char* b2 = last ? nB : cB + (size_t)(t + 2) * kstep;
            const char* a3 = a2 + kstep; const char* b3 = b2 + kstep;
            PG8_LDB(B0, 0, 0); PG8_LDB(B1, 0, 1); PG8_SCHED; PG8_LDA(At, 0, 0); PG8_STAGE(PG8_SA(1, 1), a1 + astep, voffA);
            PG8_WAIT_V(8); PG8_WAIT_L(0); PG8_BAR; PG8_MMA(0, 0, At, B0); PG8_MMA(0, 1, At, B1); PG8_BAR; PG8_SCHED;
            PG8_LDA(At, 0, 1); PG8_STAGE(PG8_SB(0, 0), b2, voffB); PG8_STAGE(PG8_SB(0, 1), b2 + hstep, voffB); PG8_STAGE(PG8_SA(0, 0), a2, voffA);
            PG8_WAIT_V(8); PG8_WAIT_L(0); PG8_BAR; PG8_MMA(1, 0, At, B0); PG8_MMA(1, 1, At, B1); PG8_BAR; PG8_SCHED;
            PG8_LDB(B0, 1, 0); PG8_LDB(B1, 1, 1); PG8_SCHED; PG8_LDA(At, 1, 0); PG8_STAGE(PG8_SA(0, 1), a2 + astep, voffA);
            PG8_WAIT_V(8); PG8_WAIT_L(0); PG8_BAR; PG8_MMA(0, 0, At, B0); PG8_MMA(0, 1, At, B1); PG8_BAR; PG8_SCHED;
            PG8_LDA(At, 1, 1); PG8_STAGE(PG8_SB(1, 0), b3, voffB); PG8_STAGE(PG8_SB(1, 1), b3 + hstep, voffB); PG8_STAGE(PG8_SA(1, 0), a3, voffA);
            PG8_WAIT_V(8); PG8_WAIT_L(0); PG8_BAR; PG8_MMA(1, 0, At, B0); PG8_MMA(1, 1, At, B1); PG8_BAR; PG8_SCHED;
        }
        if (wr == 0) PG8_BAR;
        { int fr2 = fr, fq2 = fq; asm volatile("" : "+v"(fr2), "+v"(fq2));
          E(acc, cur, wr, wc, fr2, fq2, lds, ui); }
        if (!has_next) break;
#pragma unroll
        for (int a = 0; a < 2; ++a)
#pragma unroll
            for (int b = 0; b < 2; ++b)
#pragma unroll
                for (int m = 0; m < 4; ++m)
#pragma unroll
                    for (int n = 0; n < 2; ++n) acc[a][b][m][n] = (f32x4){0.f, 0.f, 0.f, 0.f};
        cur = nxt; cA = nA; cB = nB; ++ui;
        if (wr == 1) PG8_BAR;
    }
    PG8_WAIT_V(0);
    PG8_BAR;
#undef PG8_SA
#undef PG8_SB
#undef PG8_STAGE
#undef PG8_LDA
#undef PG8_LDB
#undef PG8_MMA
#undef PG8_WAIT_V
#undef PG8_WAIT_L
#undef PG8_BAR
#undef PG8_SCHED
}

struct WItem { const float* W; const float* g; bf16_t* WT; int K, N, k0, n0, drow0; };
DI void transpose_load(const WItem& w, float (&v)[32], int lane) {
    const float* rb = w.W + (size_t)w.k0 * w.N + w.n0;
    const unsigned lo = (unsigned)(lane >> 5) * (unsigned)w.N + (unsigned)(lane & 31), hl = (unsigned)(lane >> 5);
    const float* gb = w.g ? w.g + w.k0 : nullptr;
#pragma unroll
    for (int i = 0; i < 32; ++i) { const float gv = gb ? gb[hl + 2u * i] : 1.f;
        v[i] = rb[lo + (unsigned)(2 * i) * (unsigned)w.N] * gv; }
}
DI void transpose_finish(const WItem& w, const float (&v)[32], LAS float* scr, int lane) {
#pragma unroll
    for (int i = 0; i < 32; ++i) scr[(2 * i + (lane >> 5)) * 33 + (lane & 31)] = v[i];
    asm volatile("s_waitcnt lgkmcnt(0)" ::: "memory");
    const int c = lane & 7;
#pragma unroll
    for (int j = 0; j < 4; ++j) { const int n = (lane >> 3) + 8 * j; const LAS float* sp = scr + (8 * c) * 33 + n;
        u32x4 o; o.x = pk2(sp[0], sp[33]); o.y = pk2(sp[2 * 33], sp[3 * 33]); o.z = pk2(sp[4 * 33], sp[5 * 33]); o.w = pk2(sp[6 * 33], sp[7 * 33]);
        *(u32x4*)(w.WT + (size_t)(w.drow0 + n) * w.K + w.k0 + 8 * c) = o; }
    asm volatile("s_waitcnt lgkmcnt(0)" ::: "memory");
}

constexpr int I_IN = 16 * 96, I_OUT = 16 * 32, I_UP = 16 * 176, I_DN = 44 * 32, I_L = I_IN + I_OUT + I_UP + I_DN;
DI WItem weight_desc(PP p, int it) {
    WItem w; const int l = it / I_L; int r = it % I_L;
    if (r < I_IN) { const int kb = r / 96, nb = r % 96;
        w.W = p->w_in + (size_t)l * DM * DIN; w.g = p->norm1_g + l * DM; w.K = DM; w.N = DIN; w.WT = (bf16_t*)(p->ws + WS_WIN + l * SZ_WIN); w.k0 = kb * 64; w.n0 = nb * 32; w.drow0 = nb * 32; return w; }
    r -= I_IN;
    if (r < I_OUT) { const int kb = r / 32, nb = r % 32;
        w.W = p->w_out + (size_t)l * DM * DM; w.g = nullptr; w.K = DM; w.N = DM; w.WT = (bf16_t*)(p->ws + WS_WOUT + l * SZ_WOUT); w.k0 = kb * 64; w.n0 = nb * 32; w.drow0 = nb * 32; return w; }
    r -= I_OUT;
    if (r < I_UP) { const int kb = r / 176, nb = r % 176; const int n0 = nb * 32;
        const int drow = (n0 < DFF) ? ((n0 / 128) * 256 + (n0 % 128)) : (((n0 - DFF) / 128) * 256 + 128 + ((n0 - DFF) % 128));
        w.W = p->ffn_up + (size_t)l * DM * DUP; w.g = p->norm2_g + l * DM; w.K = DM; w.N = DUP; w.WT = (bf16_t*)(p->ws + WS_WUP + l * SZ_WUP); w.k0 = kb * 64; w.n0 = n0; w.drow0 = drow; return w; }
    r -= I_UP;
    { const int kb = r / 32, nb = r % 32;
        w.W = p->ffn_down + (size_t)l * DFF * DM; w.g = nullptr; w.K = DFF; w.N = DM; w.WT = (bf16_t*)(p->ws + WS_WDN + l * SZ_WDN); w.k0 = kb * 64; w.n0 = nb * 32; w.drow0 = nb * 32; return w; }
}
DI void weight_item(PP p, int it, LAS float* scr, int lane) { const WItem w = weight_desc(p, it); float v[32]; transpose_load(w, v, lane); transpose_finish(w, v, scr, lane); }
DI void weight_item2(PP p, int it0, int it1, bool has1, LAS float* scr, int lane) {
    const WItem w0 = weight_desc(p, it0), w1 = weight_desc(p, has1 ? it1 : it0);
    float v0[32], v1[32];
    transpose_load(w0, v0, lane); transpose_load(w1, v1, lane);
    transpose_finish(w0, v0, scr, lane);
    if (has1) transpose_finish(w1, v1, scr, lane);
}

DI void phase_prep(PP p, LAS unsigned char* lds, const int tid) {
    const int lane = tid & 63, wave = __builtin_amdgcn_readfirstlane(tid >> 6);
    const int gw = blockIdx.x * 8 + wave, NGW = gridDim.x * 8;
    {
        bf16_t* xb = (bf16_t*)(p->ws + WS_XB); float* ss = (float*)(p->ws + WS_SS); const float* x = p->x;
        for (int row0 = gw * 4; row0 < T; row0 += NGW * 4) {
            f32x4 xa[4][2], xc[4][2];
#pragma unroll
            for (int q = 0; q < 4; ++q)
#pragma unroll
                for (int j = 0; j < 2; ++j) { const size_t o = (size_t)(row0 + q) * DM + 8 * lane + 512 * j; xa[q][j] = *(const f32x4*)(x + o); xc[q][j] = *(const f32x4*)(x + o + 4); }
#pragma unroll
            for (int q = 0; q < 4; ++q) {
                float sq = 0.f;
#pragma unroll
                for (int j = 0; j < 2; ++j) { const size_t o = (size_t)(row0 + q) * DM + 8 * lane + 512 * j; const f32x4 a = xa[q][j], b = xc[q][j];
                    u32x4 w; w.x = pk2(a[0], a[1]); w.y = pk2(a[2], a[3]); w.z = pk2(b[0], b[1]); w.w = pk2(b[2], b[3]);
                    *(u32x4*)(xb + o) = w;
                    sq += (bf_lo(w.x) * bf_lo(w.x) + bf_hi(w.x) * bf_hi(w.x)) + (bf_lo(w.y) * bf_lo(w.y) + bf_hi(w.y) * bf_hi(w.y))
                        + (bf_lo(w.z) * bf_lo(w.z) + bf_hi(w.z) * bf_hi(w.z)) + (bf_lo(w.w) * bf_lo(w.w) + bf_hi(w.w) * bf_hi(w.w)); }
#pragma unroll
                for (int o = 1; o < 64; o <<= 1) sq += __shfl_xor(sq, o);
                if (lane < 16) ss[(size_t)lane * T + row0 + q] = (lane == 0) ? sq : 0.f;
            }
        }
    }
    LAS float* scr = (LAS float*)(lds + wave * 8448);
    for (int it = gw; it < I_IN; it += NGW) weight_item(p, it, scr, lane);
}

struct KV { u32x4 k[4]; u32x4 v[4]; };
constexpr int NT = 23;
DI bool tile_desc(int tt, int p0, int& kbase, int& kstride, int& W, int& cls) {
    if (tt < 8) { kstride = 1; kbase = p0 - 128 + 32 * tt; W = 128; cls = -1; }
    else if (tt < 11) { kstride = 4; kbase = p0 - 512 + 128 * (tt - 8); W = 512; cls = 0; }
    else { kstride = 4; kbase = p0 - 640 - 128 * (tt - 11); W = 2048; cls = 1; }
    return kbase + kstride * 31 >= 0;
}
DI int next_tile(int tt, int p0) { int kb, ks, W, cls; for (++tt; tt < NT; ++tt) if (tile_desc(tt, p0, kb, ks, W, cls)) break; return tt; }
DI void load_kv_at(KV& t, const bf16_t* __restrict__ base, int h, int kbase, int kstride, int vrow0, int vch) {
#pragma unroll
    for (int i = 0; i < 4; ++i) { int vpos = kbase + kstride * (vrow0 + 8 * i); vpos = vpos < 0 ? 0 : vpos;
        const bf16_t* rp = base + (size_t)vpos * DIN + h * 64 + 8 * vch;
        t.k[i] = *(const u32x4*)(rp + 512); t.v[i] = *(const u32x4*)(rp + 1024); }
}
DI void load_kv(KV& t, const bf16_t* __restrict__ base, int h, int tt, int p0, const bf16_t* __restrict__ nbase, int nh, int np0, int vrow0, int vch) {
    const bool here = tt < NT;
    int kbase, kstride, W, cls; tile_desc(here ? tt : next_tile(-1, np0), here ? p0 : np0, kbase, kstride, W, cls);
    load_kv_at(t, here ? base : nbase, here ? h : nh, kbase, kstride, vrow0, vch);
}

struct AttnState { float mrun, lrun; f32x16 o0, o1; };

DI void attn_tile(AttnState& st, const KV& t, const bf16x8 (&qf)[4], int tt, int p0, int qpos, int r, int hh, int vrow0, int vch, LAS unsigned char* vptr, unsigned ta0, unsigned ta1, float slope2, float sc) {
    int kbase, kstride, W, cls; tile_desc(tt, p0, kbase, kstride, W, cls);
#pragma unroll
    for (int i = 0; i < 4; ++i) { const int vr = vrow0 + 8 * i;
        *(LAS u32x4*)(vptr + 4096 + vr * 128 + ((vch ^ (vr & 7)) << 4)) = t.k[i];
        *(LAS u32x4*)(vptr + vr * 128 + ((vch * 16) ^ (((vr >> 1) & 1) << 6))) = t.v[i]; }
    bf16x8 kf[4];
#pragma unroll
    for (int c = 0; c < 4; ++c) kf[c] = *(const LAS bf16x8*)(vptr + 4096 + r * 128 + (((2 * c + hh) ^ (r & 7)) << 4));
    f32x16 S;
#pragma unroll
    for (int i = 0; i < 16; ++i) S[i] = 0.f;
    __builtin_amdgcn_s_setprio(1);
#pragma unroll
    for (int c = 0; c < 4; ++c) S = __builtin_amdgcn_mfma_f32_32x32x16_bf16(kf[c], qf[c], S, 0, 0, 0);
    __builtin_amdgcn_s_setprio(0);
#define SC_(x) asm("" : "+v"(x))
    const float dist0 = (float)(qpos - kbase - kstride * 4 * hh), nks = -(float)kstride, nsl = -slope2;
    float sv[16];
    float tmax = -3.0e38f;
    if (cls < 0) {
        const float half = 0.5f * (float)(qpos < W ? qpos : W), dpb = dist0 - half, K0 = -slope2 * half;
        const float hq = 0.5f * (float)qpos;
        const int e3 = (r - hh) & 3; const bool pe0 = e3 == 0, pe2 = e3 == 2;
#pragma unroll
        for (int i = 0; i < 16; ++i) { const float cf = (float)((i & 3) + 8 * (i >> 2));
            float dp = __builtin_fmaf(nks, cf, dpb);
            SC_(dp);
            float sx = __builtin_fmaf(S[i], sc, __builtin_fmaf(dp, nsl, K0));
            const bool v1 = __builtin_fabsf(dp) <= half;
            if ((i & 3) == 0) {
                const bool v4 = __builtin_fabsf(dp + (half - hq)) <= hq;
                const bool v16 = (((i >> 2) & 1) ? pe2 : pe0) && v4;
                const float add = v1 ? (v16 ? 1.5849625f : 1.f) : (v16 ? 1.f : 0.f);
                sx = v4 ? sx + add : -3.0e38f;
            } else sx = v1 ? sx : -3.0e38f;
            SC_(sx);
            sv[i] = sx; tmax = fmaxf(tmax, sx); }
    } else {
        const float hA = (cls == 0) ? 0.5f * (float)(qpos < 512 ? qpos : 512) : -1.f;
        const float hB = 0.5f * (float)qpos;
        const int rc = r & 3;
#pragma unroll
        for (int i = 0; i < 16; ++i) { const float cf = (float)((i & 3) + 8 * (i >> 2));
            float dist = __builtin_fmaf(nks, cf, dist0);
            SC_(dist);
            const bool vA = __builtin_fabsf(dist - hA) <= hA;
            const bool vB = (rc == (i & 3)) && (__builtin_fabsf(dist - hB) <= hB);
            float sx = __builtin_fmaf(S[i], sc, dist * nsl);
            sx += (vA && vB) ? 1.f : 0.f;
            sx = (vA || vB) ? sx : -3.0e38f;
            SC_(sx);
            sv[i] = sx; tmax = fmaxf(tmax, sx); }
    }
    s16x4 t0, t1, t2, t3, t4, t5, t6, t7;
    asm volatile("s_waitcnt lgkmcnt(0)\n\t"
                 "ds_read_b64_tr_b16 %0, %8\n\tds_read_b64_tr_b16 %1, %8 offset:1024\n\tds_read_b64_tr_b16 %2, %8 offset:2048\n\tds_read_b64_tr_b16 %3, %8 offset:3072\n\t"
                 "ds_read_b64_tr_b16 %4, %9\n\tds_read_b64_tr_b16 %5, %9 offset:1024\n\tds_read_b64_tr_b16 %6, %9 offset:2048\n\tds_read_b64_tr_b16 %7, %9 offset:3072"
                 : "=&v"(t0), "=&v"(t1), "=&v"(t2), "=&v"(t3), "=&v"(t4), "=&v"(t5), "=&v"(t6), "=&v"(t7) : "v"(ta0), "v"(ta1) : "memory");
    if (__builtin_amdgcn_ballot_w64(tmax > st.mrun + 8.f) != 0ull) {
        tmax = fmaxf(tmax, __shfl_xor(tmax, 32));
        const float mnew = fmaxf(st.mrun, tmax), alpha = __builtin_amdgcn_exp2f(st.mrun - mnew); st.mrun = mnew;
        st.lrun *= alpha;
#pragma unroll
        for (int i = 0; i < 16; ++i) { float a0 = st.o0[i] * alpha, a1 = st.o1[i] * alpha; SC_(a0); SC_(a1); st.o0[i] = a0; st.o1[i] = a1; }
    }
    const float mn = st.mrun;
    float psum = 0.f;
#pragma unroll
    for (int i = 0; i < 16; ++i) { float e = sv[i] - mn; SC_(e); float pv = __builtin_amdgcn_exp2f(e); SC_(pv); S[i] = pv; psum += pv; }
    st.lrun += psum;
#undef SC_
    bf16x8 pf[2];
#pragma unroll
    for (int s = 0; s < 2; ++s) { u32x4 w; w.x = pk2(S[8 * s], S[8 * s + 1]); w.y = pk2(S[8 * s + 2], S[8 * s + 3]); w.z = pk2(S[8 * s + 4], S[8 * s + 5]); w.w = pk2(S[8 * s + 6], S[8 * s + 7]);
        pf[s] = __builtin_bit_cast(bf16x8, w); }
    asm volatile("s_waitcnt lgkmcnt(0)" : "+v"(t0), "+v"(t1), "+v"(t2), "+v"(t3), "+v"(t4), "+v"(t5), "+v"(t6), "+v"(t7) :: "memory");
    const bf16x8 v00 = __builtin_shufflevector(t0, t1, 0, 1, 2, 3, 4, 5, 6, 7), v01 = __builtin_shufflevector(t2, t3, 0, 1, 2, 3, 4, 5, 6, 7);
    const bf16x8 v10 = __builtin_shufflevector(t4, t5, 0, 1, 2, 3, 4, 5, 6, 7), v11 = __builtin_shufflevector(t6, t7, 0, 1, 2, 3, 4, 5, 6, 7);
    __builtin_amdgcn_s_setprio(1);
    st.o0 = __builtin_amdgcn_mfma_f32_32x32x16_bf16(v00, pf[0], st.o0, 0, 0, 0);
    st.o0 = __builtin_amdgcn_mfma_f32_32x32x16_bf16(v01, pf[1], st.o0, 0, 0, 0);
    st.o1 = __builtin_amdgcn_mfma_f32_32x32x16_bf16(v10, pf[0], st.o1, 0, 0, 0);
    st.o1 = __builtin_amdgcn_mfma_f32_32x32x16_bf16(v11, pf[1], st.o1, 0, 0, 0);
    __builtin_amdgcn_s_setprio(0);
}

DI void attn_item(const bf16_t* __restrict__ proj, bf16_t* __restrict__ mixed, const float* __restrict__ og, unsigned vlds, LAS unsigned char* vptr, int b, int h, int p0,
                  int nb, int nh, int np0, KV& ta, bf16x8 (&qf)[4], int lane) {
    const int r = lane & 31, hh = lane >> 5;
    const bf16_t* base = proj + (size_t)b * SEQ * DIN; const bf16_t* nbase = proj + (size_t)nb * SEQ * DIN;
    const int qpos = p0 + 4 * r;
    AttnState st; st.mrun = -1e30f; st.lrun = 0.f;
#pragma unroll
    for (int i = 0; i < 16; ++i) { st.o0[i] = 0.f; st.o1[i] = 0.f; }
    const float slope2 = __builtin_amdgcn_exp2f(-(float)(h + 1)) * 1.44269504089f;
    const float sc = 0.125f * 1.44269504089f;
    const int i16 = lane & 15, tq = i16 >> 2, tp = i16 & 3, gsub = (lane >> 4) & 1;
    const unsigned ta0 = vlds + (unsigned)((4 * hh + tq) * 128 + ((32 * gsub + 8 * tp) ^ (64 * ((tq >> 1) & 1))));
    const unsigned ta1 = ta0 ^ 64u;
    const int vrow0 = lane >> 3, vch = lane & 7;
    KV tb;
    int cur = next_tile(-1, p0);
    bool in_tb;
    for (;;) {
        int nxt = next_tile(cur, p0);
        load_kv(tb, base, h, nxt, p0, nbase, nh, np0, vrow0, vch);
        attn_tile(st, ta, qf, cur, p0, qpos, r, hh, vrow0, vch, vptr, ta0, ta1, slope2, sc);
        if (nxt >= NT) { in_tb = true; break; }
        cur = nxt; nxt = next_tile(cur, p0);
        load_kv(ta, base, h, nxt, p0, nbase, nh, np0, vrow0, vch);
        attn_tile(st, tb, qf, cur, p0, qpos, r, hh, vrow0, vch, vptr, ta0, ta1, slope2, sc);
        if (nxt >= NT) { in_tb = false; break; }
        cur = nxt;
    }
    { const int nq = np0 + 4 * r;
#pragma unroll
      for (int c = 0; c < 4; ++c) qf[c] = *(const bf16x8*)(nbase + (size_t)nq * DIN + nh * 64 + 16 * c + 8 * hh); }
    float lrun = st.lrun + __shfl_xor(st.lrun, 32);
    const float inv = 1.f / lrun;
    float ssq = 0.f;
#pragma unroll
    for (int i = 0; i < 16; ++i) { st.o0[i] *= inv; st.o1[i] *= inv; ssq += st.o0[i] * st.o0[i] + st.o1[i] * st.o1[i]; }
    ssq += __shfl_xor(ssq, 32);
    const float rstd = rsqrtf(ssq * (1.f / 64.f) + EPS);
    bf16_t* orow = mixed + ((size_t)b * SEQ + qpos) * DM + h * 64;
#pragma unroll
    for (int gi = 0; gi < 4; ++gi) { const int d0 = 8 * gi + 4 * hh;
        const f32x4 g0 = *(const f32x4*)(og + h * 64 + d0), g1 = *(const f32x4*)(og + h * 64 + 32 + d0);
        u32x2 w0, w1;
        w0.x = pk2(st.o0[4 * gi] * rstd * g0[0], st.o0[4 * gi + 1] * rstd * g0[1]); w0.y = pk2(st.o0[4 * gi + 2] * rstd * g0[2], st.o0[4 * gi + 3] * rstd * g0[3]);
        w1.x = pk2(st.o1[4 * gi] * rstd * g1[0], st.o1[4 * gi + 1] * rstd * g1[1]); w1.y = pk2(st.o1[4 * gi + 2] * rstd * g1[2], st.o1[4 * gi + 3] * rstd * g1[3]);
        *(u32x2*)(orow + d0) = w0; *(u32x2*)(orow + 32 + d0) = w1; }
    if (in_tb) ta = tb;
}

DI void unpack8(const u32x4 v, float (&f)[8]) { f[0] = bf_lo(v.x); f[1] = bf_hi(v.x); f[2] = bf_lo(v.y); f[3] = bf_hi(v.y); f[4] = bf_lo(v.z); f[5] = bf_hi(v.z); f[6] = bf_lo(v.w); f[7] = bf_hi(v.w); }

DI void phase_mixer(PP p, int layer, LAS unsigned char* lds, const int tid) {
    const int lane = tid & 63, wave = __builtin_amdgcn_readfirstlane(tid >> 6);
    const bf16_t* proj = (const bf16_t*)(p->ws + WS_PROJ); bf16_t* mixed = (bf16_t*)(p->ws + WS_MIX);
    const int G = gridDim.x, bid = blockIdx.x;
    const int vB = (G % 8 == 0) ? ((bid % 8) * (G / 8) + bid / 8) : bid;
    {
        const float* cw = p->mix_conv_w + (size_t)layer * 3 * 512; const float* cg_ = p->conv_out_g + (size_t)layer * 512;
        const int ch0 = 8 * lane; const int NW = G * 8, gw = vB * 8 + wave; const int per = T / NW;
        float w0[8], w1[8], w2[8], gg[8];
#pragma unroll
        for (int i = 0; i < 8; ++i) { w0[i] = cw[ch0 + i]; w1[i] = cw[512 + ch0 + i]; w2[i] = cw[1024 + ch0 + i]; gg[i] = cg_[ch0 + i]; }
        const int t0 = gw * per;
        float p1[8], p2[8];
#pragma unroll
        for (int i = 0; i < 8; ++i) { p1[i] = 0.f; p2[i] = 0.f; }
        if ((t0 % SEQ) != 0) {
            float a[8], c[8];
            unpack8(*(const u32x4*)(proj + (size_t)(t0 - 2) * DIN + 2048 + ch0), a); unpack8(*(const u32x4*)(proj + (size_t)(t0 - 2) * DIN + 2560 + ch0), c);
#pragma unroll
            for (int i = 0; i < 8; ++i) p2[i] = a[i] * c[i];
            unpack8(*(const u32x4*)(proj + (size_t)(t0 - 1) * DIN + 2048 + ch0), a); unpack8(*(const u32x4*)(proj + (size_t)(t0 - 1) * DIN + 2560 + ch0), c);
#pragma unroll
            for (int i = 0; i < 8; ++i) p1[i] = a[i] * c[i];
        }
        for (int t = t0; t < t0 + per; t += 4) {
            u32x4 rb[4], ra[4], rc[4];
#pragma unroll
            for (int q = 0; q < 4; ++q) { const bf16_t* pr = proj + (size_t)(t + q) * DIN + ch0; rb[q] = *(const u32x4*)(pr + 1536); ra[q] = *(const u32x4*)(pr + 2048); rc[q] = *(const u32x4*)(pr + 2560); }
#pragma unroll
            for (int q = 0; q < 4; ++q) {
                float gb[8], a[8], c[8], y[8];
                unpack8(rb[q], gb); unpack8(ra[q], a); unpack8(rc[q], c);
                float sq = 0.f;
#pragma unroll
                for (int i = 0; i < 8; ++i) { const float cu = a[i] * c[i]; y[i] = gb[i] * (w0[i] * p2[i] + w1[i] * p1[i] + w2[i] * cu); p2[i] = p1[i]; p1[i] = cu; sq += y[i] * y[i]; }
                sq += __shfl_xor(sq, 1); sq += __shfl_xor(sq, 2); sq += __shfl_xor(sq, 4);
                const float rs = rsqrtf(sq * (1.f / 64.f) + EPS);
                u32x4 o; o.x = pk2(y[0] * rs * gg[0], y[1] * rs * gg[1]); o.y = pk2(y[2] * rs * gg[2], y[3] * rs * gg[3]); o.z = pk2(y[4] * rs * gg[4], y[5] * rs * gg[5]); o.w = pk2(y[6] * rs * gg[6], y[7] * rs * gg[7]);
                *(u32x4*)(mixed + (size_t)(t + q) * DM + 512 + ch0) = o;
            }
        }
    }
    {
        const float* og = p->attn_out_g + (size_t)layer * 512;
        LAS unsigned char* vptr = lds + wave * 8192; const unsigned vlds = (unsigned)(size_t)vptr;
        if (G == 256) {
            const int xcd = vB / 32, wl = (vB % 32) * 8 + wave;
            LAS float* scr = (LAS float*)(lds + 65536 + wave * 8448); const int gw = bid * 8 + wave; int wit = I_IN + gw;
            KV ta; bf16x8 qf[4];
            { const int bh = xcd * 16 + wl / 64, c = wl % 64, p0 = 128 * (c >> 2) + (c & 3);
              const bf16_t* base = proj + (size_t)(bh >> 3) * SEQ * DIN; const int r = lane & 31, hh = lane >> 5;
#pragma unroll
              for (int cc = 0; cc < 4; ++cc) qf[cc] = *(const bf16x8*)(base + (size_t)(p0 + 4 * r) * DIN + (bh & 7) * 64 + 16 * cc + 8 * hh);
              int kb, ks, W, cls; tile_desc(next_tile(-1, p0), p0, kb, ks, W, cls); load_kv_at(ta, base, bh & 7, kb, ks, lane >> 3, lane & 7); }
            for (int k = 0; k < 4; ++k) {
                const int bh = xcd * 16 + k * 4 + wl / 64, c = (wl % 64 + 16 * k) % 64;
                const int kn = k < 3 ? k + 1 : k, nbh = xcd * 16 + kn * 4 + wl / 64, nc = (wl % 64 + 16 * kn) % 64;
                attn_item(proj, mixed, og, vlds, vptr, bh >> 3, bh & 7, 128 * (c >> 2) + (c & 3), nbh >> 3, nbh & 7, 128 * (nc >> 2) + (nc & 3), ta, qf, lane);
                if (layer == 0 && wit < NL * I_L) { weight_item2(p, wit, wit + G * 8, wit + G * 8 < NL * I_L, scr, lane); wit += 2 * G * 8; }
            }
        }
    }
}

DI void fixup_tile(PP p, int layer, const int tid, const int pm) {
    if ((pm & 7) == 0) return;
    const float* H = (const float*)(p->ws + WS_H); bf16_t* act = (bf16_t*)(p->ws + WS_PROJ); const float* cw = p->ffn_conv_w + (size_t)layer * 3 * DUP;
    const float* Hc = H + (size_t)pm * 4 * DUP; const float* Hp = H + (size_t)(pm - 1) * 4 * DUP;
    for (int idx = tid; idx < 2 * DFF; idx += 512) {
        const int i = idx / DFF, c = idx % DFF;
        const int gcol = (c >> 7) * 256 + (c & 127), vcol = gcol + 128;
        float g0, g1, g2, v0, v1, v2;
        if (i == 0) { g0 = Hc[gcol]; g1 = Hp[3 * DUP + gcol]; g2 = Hp[2 * DUP + gcol]; v0 = Hc[vcol]; v1 = Hp[3 * DUP + vcol]; v2 = Hp[2 * DUP + vcol]; }
        else { g0 = Hc[DUP + gcol]; g1 = Hc[gcol]; g2 = Hp[3 * DUP + gcol]; v0 = Hc[DUP + vcol]; v1 = Hc[vcol]; v2 = Hp[3 * DUP + vcol]; }
        const float yg = cw[2 * DUP + c] * g0 + cw[DUP + c] * g1 + cw[c] * g2;
        const float yv = cw[2 * DUP + DFF + c] * v0 + cw[DUP + DFF + c] * v1 + cw[DFF + c] * v2;
        const float a = silu_mul(yg, yv);
        const unsigned pk = pk2(a, a);
        act[(size_t)(pm * 256 + i) * DFF + c] = (bf16_t)(pk & 0xffffu);
    }
}

DI void phase_final(PP p, const int tid) {
    const int lane = tid & 63, wave = tid >> 6; const float* ss = (const float*)(p->ws + WS_SS); const bf16_t* xb = (const bf16_t*)(p->ws + WS_XB);
    f32x4 g[4];
#pragma unroll
    for (int j = 0; j < 2; ++j) { g[2 * j] = *(const f32x4*)(p->final_norm_g + 8 * lane + 512 * j); g[2 * j + 1] = *(const f32x4*)(p->final_norm_g + 8 * lane + 512 * j + 4); }
    for (int row0 = (blockIdx.x * 8 + wave) * 4; row0 < T; row0 += gridDim.x * 8 * 4) {
        u32x4 xv[4][2]; float sr[4];
#pragma unroll
        for (int q = 0; q < 4; ++q) {
#pragma unroll
            for (int j = 0; j < 2; ++j) xv[q][j] = *(const u32x4*)(xb + (size_t)(row0 + q) * DM + 8 * lane + 512 * j);
            float s = 0.f;
#pragma unroll
            for (int pl = 0; pl < 16; ++pl) s += ss[(size_t)pl * T + row0 + q];
            sr[q] = rsqrtf(s * (1.f / DM) + EPS);
        }
#pragma unroll
        for (int q = 0; q < 4; ++q)
#pragma unroll
            for (int j = 0; j < 2; ++j) { const size_t o = (size_t)(row0 + q) * DM + 8 * lane + 512 * j; const u32x4 x4 = xv[q][j]; const float rs = sr[q];
                f32x4 v0 = {bf_lo(x4.x), bf_hi(x4.x), bf_lo(x4.y), bf_hi(x4.y)}, v1 = {bf_lo(x4.z), bf_hi(x4.z), bf_lo(x4.w), bf_hi(x4.w)};
                *(f32x4*)(p->out + o) = v0 * rs * g[2 * j]; *(f32x4*)(p->out + o + 4) = v1 * rs * g[2 * j + 1]; }
    }
}

#define XB_TMO      128
#define XB_XCNT(j)  (256  + 64 * (j))
#define XB_XSUB(j)  (1280 + 64 * (j))
#define XB_XGEN(j)  (2304 + 64 * (j))
#define XB_TOP      3328
#define XB_TOPGEN   3392
#define XCD_BAR_WORDS 3456
#define XB_SPIN_CAP (1u << 18)
DI unsigned xb_ld(unsigned* p)              { return __hip_atomic_load(p, __ATOMIC_RELAXED, __HIP_MEMORY_SCOPE_AGENT); }
DI unsigned xb_add(unsigned* p, unsigned v) { return __hip_atomic_fetch_add(p, v, __ATOMIC_RELAXED, __HIP_MEMORY_SCOPE_AGENT); }
DI unsigned xb_xcc_id() { return (unsigned)__builtin_amdgcn_s_getreg((3 << 11) | 20) & 0xFu; }
#define XB_SPIN(cond, bar) do { unsigned _sp = 0; while (cond) { __builtin_amdgcn_s_sleep(1); \
    if ((++_sp & 255u) == 0u) { if (xb_ld(&(bar)[XB_TMO])) break; if (_sp > XB_SPIN_CAP) { atomicAdd(&(bar)[XB_TMO], 1u); break; } } } } while (0)
struct XcdBarrier { unsigned* bar; unsigned x; volatile LAS unsigned* st; };
DI XcdBarrier xcd_barrier_post(unsigned* bar, volatile LAS unsigned* st) {
    XcdBarrier b; b.bar = bar; b.x = xb_xcc_id(); b.st = st;
    if (threadIdx.x == 0) (void)xb_add(&bar[XB_XCNT(b.x)], 1u);
    return b;
}
DI void xcd_barrier_complete(unsigned* bar, unsigned x, unsigned& nloc, unsigned& nx) {
    const unsigned G = gridDim.x * gridDim.y * gridDim.z;
    unsigned sum, cnt, mine, sp = 0u;
    for (;;) {
        sum = 0u; cnt = 0u; mine = 0u;
#pragma unroll
        for (unsigned j = 0; j < 16; ++j) { const unsigned c = xb_ld(&bar[XB_XCNT(j)]); sum += c; cnt += (c > 0u) ? 1u : 0u; mine = (j == x) ? c : mine; }
        if (sum == G) break;
        __builtin_amdgcn_s_sleep(1);
        if ((++sp & 255u) == 0u) { if (xb_ld(&bar[XB_TMO])) break; if (sp > XB_SPIN_CAP) { atomicAdd(&bar[XB_TMO], 1u); break; } }
    }
    nloc = mine > 0u ? mine : 1u; nx = cnt > 0u ? cnt : 1u;
}
DI void xcd_barrier(const XcdBarrier& b, const int tid) {
    asm volatile("s_waitcnt vmcnt(0)" ::: "memory");
    __syncthreads();
    if (tid == 0) {
        unsigned* bar = b.bar; asm volatile("" : "+s"(bar));
        __builtin_amdgcn_s_waitcnt(0);
        unsigned nloc = b.st[0], nx = b.st[1];
        if (nloc == 0u) { xcd_barrier_complete(bar, b.x, nloc, nx); b.st[0] = nloc; b.st[1] = nx; }
        const unsigned old = xb_add(&bar[XB_XSUB(b.x)], 1u);
        const unsigned gen = old / nloc;
        if (old + 1u == (gen + 1u) * nloc) {
            __builtin_amdgcn_fence(__ATOMIC_RELEASE, "agent");
            asm volatile("s_waitcnt vmcnt(0)" ::: "memory");
            const unsigned og = xb_add(&bar[XB_TOP], 1u);
            const unsigned tg = og / nx;
            if (og + 1u == (tg + 1u) * nx) xb_add(&bar[XB_TOPGEN], 1u);
            else XB_SPIN(xb_ld(&bar[XB_TOPGEN]) == tg, bar);
            __builtin_amdgcn_fence(__ATOMIC_ACQUIRE, "agent");
            xb_add(&bar[XB_XGEN(b.x)], 1u);
            asm volatile("s_waitcnt vmcnt(0)" ::: "memory");
        } else {
            XB_SPIN(xb_ld(&bar[XB_XGEN(b.x)]) == gen, bar);
            __builtin_amdgcn_fence(__ATOMIC_ACQUIRE, "agent");
            asm volatile("s_waitcnt vmcnt(0)" ::: "memory");
        }
    }
    __syncthreads();
}

__global__ __launch_bounds__(512, 2) void fwd_kernel(Params parg) {
    extern __shared__ __attribute__((aligned(16))) unsigned char shm[];
    LAS unsigned char* lds = (LAS unsigned char*)shm;
    const int ph_lo = parg.ph_lo, ph_hi = parg.ph_hi, coop = parg.coop;
    const int wave_id = __builtin_amdgcn_readfirstlane((int)(threadIdx.x >> 6));
    volatile LAS unsigned* xst = (volatile LAS unsigned*)(lds + XB_ST_OFF);
    if (threadIdx.x == 0) { xst[0] = 0u; xst[1] = 0u; xst[2] = 0u; xst[3] = 0u; }
    __syncthreads();
    XcdBarrier xb_; xb_.bar = (unsigned*)(parg.ws + WS_BAR); xb_.x = 0; xb_.st = xst;
    if (coop == 1) xb_ = xcd_barrier_post((unsigned*)(parg.ws + WS_BAR), xst);
#ifdef PROBE_REP
    for (int ph2 = ph_lo; ph2 < ph_hi + 1; ++ph2) {
        const int ph = ph2 <= PROBE_REP ? ph2 : ph2 - 1;
#else
    for (int ph = ph_lo; ph < ph_hi; ++ph) {
#endif
        int wv_ = wave_id; asm volatile("" : "+s"(wv_));
        int tid = wv_ * 64 + (int)__builtin_amdgcn_mbcnt_hi(~0u, __builtin_amdgcn_mbcnt_lo(~0u, 0u)); asm volatile("" : "+v"(tid));
        PP p = (PP)__builtin_amdgcn_kernarg_segment_ptr(); asm volatile("" : "+s"(p));
        unsigned char* ws = p->ws;
        bf16_t* xb = (bf16_t*)(ws + WS_XB); float* ss = (float*)(ws + WS_SS);
        StaticOrder S;
        if (ph == 0) phase_prep(p, lds, tid);
        else if (ph == NPHASE - 1) phase_final(p, tid);
        else {
            const int layer = (ph - 1) / 5, sub = (ph - 1) % 5;
            if (sub == 0) {
                Gemm g; g.A = xb; g.Bt = (const bf16_t*)(ws + WS_WIN + layer * SZ_WIN); g.M = T; g.N = DIN; g.K = DM;
                EpiProj E; E.O = (bf16_t*)(ws + WS_PROJ); E.ss = ss;
                S.init(g.M, g.N, (int)gridDim.x, (int)blockIdx.x);
                rstd_table(lds, S, ss, tid);
                gemm_phase<EpiProj>(lds, g, S, E, tid);
            } else if (sub == 1) {
                phase_mixer(p, layer, lds, tid);
            } else if (sub == 2 || sub == 4) {
                Gemm g; g.M = T; g.N = DM;
                if (sub == 2) { g.A = (const bf16_t*)(ws + WS_MIX); g.Bt = (const bf16_t*)(ws + WS_WOUT + layer * SZ_WOUT); g.K = DM; }
                else { g.A = (const bf16_t*)(ws + WS_PROJ); g.Bt = (const bf16_t*)(ws + WS_WDN + layer * SZ_WDN); g.K = DFF; }
                EpiRes E; E.xb = xb; E.ss = ss;
                S.init(g.M, g.N, (int)gridDim.x, (int)blockIdx.x);
                if (sub == 4) {
                    Unit u; for (int i = 0; S.next(i, u); ++i) fixup_tile(p, layer, tid, u.pm);
                    asm volatile("s_waitcnt vmcnt(0)" ::: "memory"); __syncthreads();
                }
                gemm_phase<EpiRes>(lds, g, S, E, tid);
            } else {
                Gemm g; g.A = xb; g.Bt = (const bf16_t*)(ws + WS_WUP + layer * SZ_WUP); g.M = T; g.N = DUP; g.K = DM;
                EpiUp E; E.act = (bf16_t*)(ws + WS_PROJ); E.ss = ss; E.cw = p->ffn_conv_w + (size_t)layer * 3 * DUP; E.H = (float*)(ws + WS_H);
                S.init(g.M, g.N, (int)gridDim.x, (int)blockIdx.x);
                gemm_phase<EpiUp>(lds, g, S, E, tid);
            }
        }
#ifdef PROBE_REP
        if (ph2 < ph_hi) { if (coop == 1) xcd_barrier(xb_, tid); else if (coop == 2) cg::this_grid().sync(); }
#else
        if (ph + 1 < ph_hi) { if (coop == 1) xcd_barrier(xb_, tid); else if (coop == 2) cg::this_grid().sync(); }
#endif
    }
}

extern "C" void kernel_launch(void* const* d_in, const int* in_sizes, int n_in, void* d_out, int out_size, void* d_ws, size_t ws_size, hipStream_t stream) {
    static int grid = 0;
    if (grid == 0) {
        if (n_in != 12 || out_size != T * DM || ws_size < WS_END) { fprintf(stderr, "kernel_launch: unexpected shapes (n_in %d out %d ws %zu need %zu)\n", n_in, out_size, ws_size, (size_t)WS_END); grid = -1; return; }
        int dev = 0, cus = 0, per_cu = 0;
        (void)hipGetDevice(&dev); (void)hipDeviceGetAttribute(&cus, hipDeviceAttributeMultiprocessorCount, dev);
        if (hipFuncSetAttribute((const void*)fwd_kernel, hipFuncAttributeMaxDynamicSharedMemorySize, LDS_BYTES) != hipSuccess) { fprintf(stderr, "hipFuncSetAttribute failed\n"); grid = -1; return; }
        (void)hipOccupancyMaxActiveBlocksPerMultiprocessor(&per_cu, (const void*)fwd_kernel, 512, LDS_BYTES);
        if (per_cu < 1) per_cu = 1;
        (void)hipGetLastError();
        grid = cus;
    }
    if (grid < 0) return;
    Params p{};
    p.x = (const float*)d_in[0]; p.norm1_g = (const float*)d_in[1]; p.w_in = (const float*)d_in[2]; p.mix_conv_w = (const float*)d_in[3];
    p.attn_out_g = (const float*)d_in[4]; p.conv_out_g = (const float*)d_in[5]; p.w_out = (const float*)d_in[6]; p.norm2_g = (const float*)d_in[7];
    p.ffn_up = (const float*)d_in[8]; p.ffn_conv_w = (const float*)d_in[9]; p.ffn_down = (const float*)d_in[10]; p.final_norm_g = (const float*)d_in[11];
    p.out = (float*)d_out; p.ws = (unsigned char*)d_ws; p.pad = 0;
#if defined(MULTI_LAUNCH)
    for (int ph = 0; ph < NPHASE; ++ph) { p.ph_lo = ph; p.ph_hi = ph + 1; p.coop = 0;
        hipLaunchKernelGGL(fwd_kernel, dim3(grid), dim3(512), LDS_BYTES, stream, p); }
#else
    p.ph_lo = 0; p.ph_hi = NPHASE; p.coop = 1;
    if (hipMemsetAsync((char*)d_ws + WS_BAR, 0, 16384, stream) != hipSuccess) { fprintf(stderr, "memset of barrier words failed\n"); return; }
    void* args[] = {&p};
    hipError_t e = hipLaunchCooperativeKernel((const void*)fwd_kernel, dim3(grid), dim3(512), args, LDS_BYTES, stream);
    if (e != hipSuccess) fprintf(stderr, "cooperative launch failed: %s (grid %d)\n", hipGetErrorString(e), grid);
#endif
}
```
